# Optimizing an MI355X kernel written in HIP

```python
import jax, jax.numpy as jnp
from jax import lax
import numpy as np

D_MODEL = 2048
BATCH = 2
SEQ = 8192
DEPTH = 4
DEC_BATCH = 1
DEC_SEQ = 16384
PAST_LEN = 128

N_MIXERS = 2
N_POOL_LAYERS = (DEPTH + 1) // 2
N_SGU_LAYERS = DEPTH // 2
POOL_WINDOWS = (2, 4, 8, 16)
N_POOL_GROUPS = len(POOL_WINDOWS)
POOL_GROUP = D_MODEL // N_POOL_GROUPS
SGU_CHUNK = 128
SGU_FF = 6 * D_MODEL
SGU_HALF = SGU_FF // 2
N_SGU_HEADS = 8
SGU_HEAD_DIM = SGU_HALF // N_SGU_HEADS
D_FF = 4 * D_MODEL
N_MOD = 6
EPS = 1e-6

kernel_name = "hybrid_pool_sgu_adaln_encoder"


def _rmsnorm(x, g):
    xf = x.astype(jnp.float32)
    y = xf * lax.rsqrt(jnp.mean(xf * xf, axis=-1, keepdims=True) + EPS)
    return (y * g.astype(jnp.float32)).astype(x.dtype)


def _modulate(h, shift, scale):
    return h * (1 + scale[:, None, :]) + shift[:, None, :]


def _pool_mixer(h, w_in, w_grp, scale, w_out):
    z = jnp.einsum('bsd,de->bse', h, w_in)
    S = z.shape[1]
    zf = z.astype(jnp.float32)
    cs = jnp.pad(jnp.cumsum(zf, axis=1), ((0, 0), (1, 0), (0, 0)))
    pos = jnp.arange(S)
    outs = []
    for g, w in enumerate(POOL_WINDOWS):
        sl = slice(g * POOL_GROUP, (g + 1) * POOL_GROUP)
        lo = jnp.maximum(pos - w // 2, 0)
        hi = jnp.minimum(pos + w // 2 - 1, S - 1) + 1
        csg = cs[:, :, sl]
        cnt = (hi - lo).astype(jnp.float32)[None, :, None]
        mean = (csg[:, hi] - csg[:, lo]) / cnt
        diff = (mean - zf[:, :, sl]).astype(h.dtype)
        outs.append(jnp.einsum('bsc,ce->bse', diff, w_grp[g]))
    y = jnp.concatenate(outs, axis=-1) * scale
    return jnp.einsum('bsd,de->bse', y, w_out)


def _sgu_mixer(h, w_in, v_gain, w_s, b_s, w_out):
    z = jax.nn.gelu(jnp.einsum('bsd,df->bsf', h, w_in), approximate=False)
    u, v = jnp.split(z, 2, axis=-1)
    v = _rmsnorm(v, v_gain)
    B, S, _ = v.shape
    n_chunks = S // SGU_CHUNK
    vc = v.reshape(B, n_chunks, SGU_CHUNK, N_SGU_HEADS, SGU_HEAD_DIM)
    mixed = jnp.einsum('hpq,bnqhd->bnphd', w_s, vc) + b_s.T[None, None, :, :, None]
    gated = u * mixed.reshape(B, S, SGU_HALF)
    return jnp.einsum('bsf,fd->bsd', gated, w_out)


def _channel_mlp(h, w1, w2):
    a = jnp.maximum(jnp.einsum('bsd,df->bsf', h, w1), 0)
    return jnp.einsum('bsf,fd->bsd', a * a, w2)


def _trunk(x, c, norm1_g, norm2_g, mod_w, mod_b,
           pool_w_in, pool_w_grp, pool_scale, pool_w_out,
           sgu_w_in, sgu_v_gain, sgu_w_s, sgu_b_s, sgu_w_out,
           mlp_w1, mlp_w2, final_g):
    c_act = jax.nn.silu(c)
    for i in range(DEPTH):
        mod = jnp.einsum('bd,de->be', c_act, mod_w[i]) + mod_b[i]
        sh1, sc1, g1, sh2, sc2, g2 = jnp.split(mod, N_MOD, axis=-1)
        h = _modulate(_rmsnorm(x, norm1_g[i]), sh1, sc1)
        j = i // N_MIXERS
        if i % N_MIXERS == 0:
            y = _pool_mixer(h, pool_w_in[j], pool_w_grp[j], pool_scale[j], pool_w_out[j])
        else:
            y = _sgu_mixer(h, sgu_w_in[j], sgu_v_gain[j], sgu_w_s[j], sgu_b_s[j], sgu_w_out[j])
        x = x + g1[:, None, :] * y
        h = _modulate(_rmsnorm(x, norm2_g[i]), sh2, sc2)
        x = x + g2[:, None, :] * _channel_mlp(h, mlp_w1[i], mlp_w2[i])
    return _rmsnorm(x, final_g)


def setup_inputs(seed: int = 0) -> dict:
    key = jax.random.key(seed)
    ks = jax.random.split(key, 24)
    f32 = jnp.float32
    D = D_MODEL

    def nrm(k, shape, scale):
        return jax.random.normal(k, shape, f32) * scale

    return {
        "x_prompt": nrm(ks[0], (BATCH, SEQ, D), 1.0),
        "x_sample": nrm(ks[1], (DEC_BATCH, DEC_SEQ, D), 1.0),
        "c_prompt": nrm(ks[2], (BATCH, D), 1.0),
        "c_sample": nrm(ks[3], (DEC_BATCH, D), 1.0),
        "norm1_g": 1.0 + nrm(ks[4], (DEPTH, D), 0.05),
        "norm2_g": 1.0 + nrm(ks[5], (DEPTH, D), 0.05),
        "mod_w": nrm(ks[6], (DEPTH, D, N_MOD * D), 0.5 * D ** -0.5),
        "mod_b": nrm(ks[7], (DEPTH, N_MOD * D), 0.01),
        "pool_w_in": nrm(ks[8], (N_POOL_LAYERS, D, D), D ** -0.5),
        "pool_w_grp": nrm(ks[9], (N_POOL_LAYERS, N_POOL_GROUPS, POOL_GROUP, POOL_GROUP), POOL_GROUP ** -0.5),
        "pool_scale": 1.0 + nrm(ks[10], (N_POOL_LAYERS, D), 0.1),
        "pool_w_out": nrm(ks[11], (N_POOL_LAYERS, D, D), D ** -0.5),
        "sgu_w_in": nrm(ks[12], (N_SGU_LAYERS, D, SGU_FF), D ** -0.5),
        "sgu_v_gain": 1.0 + nrm(ks[13], (N_SGU_LAYERS, SGU_HALF), 0.05),
        "sgu_w_s": nrm(ks[14], (N_SGU_LAYERS, N_SGU_HEADS, SGU_CHUNK, SGU_CHUNK), SGU_CHUNK ** -0.5),
        "sgu_b_s": 1.0 + nrm(ks[15], (N_SGU_LAYERS, N_SGU_HEADS, SGU_CHUNK), 0.1),
        "sgu_w_out": nrm(ks[16], (N_SGU_LAYERS, SGU_HALF, D), SGU_HALF ** -0.5),
        "mlp_w1": nrm(ks[17], (DEPTH, D, D_FF), D ** -0.5),
        "mlp_w2": nrm(ks[18], (DEPTH, D_FF, D), D_FF ** -0.5),
        "final_g": 1.0 + nrm(ks[19], (D,), 0.05),
    }


def reference(x_prompt, x_sample, c_prompt, c_sample, norm1_g, norm2_g, mod_w, mod_b,
              pool_w_in, pool_w_grp, pool_scale, pool_w_out,
              sgu_w_in, sgu_v_gain, sgu_w_s, sgu_b_s, sgu_w_out,
              mlp_w1, mlp_w2, final_g):
    y_prompt = _trunk(x_prompt, c_prompt, norm1_g, norm2_g, mod_w, mod_b,
                      pool_w_in, pool_w_grp, pool_scale, pool_w_out,
                      sgu_w_in, sgu_v_gain, sgu_w_s, sgu_b_s, sgu_w_out,
                      mlp_w1, mlp_w2, final_g)
    y_sample = _trunk(x_sample, c_sample, norm1_g, norm2_g, mod_w, mod_b,
                      pool_w_in, pool_w_grp, pool_scale, pool_w_out,
                      sgu_w_in, sgu_v_gain, sgu_w_s, sgu_b_s, sgu_w_out,
                      mlp_w1, mlp_w2, final_g)
    return (y_prompt, y_sample)
```

```cpp
#include <hip/hip_runtime.h>
#include <cstdio>
#include <cstdint>

#ifndef SKIP_NORM
#define SKIP_NORM 0
#endif
#ifndef SKIP_POOL
#define SKIP_POOL 0
#endif
#ifndef SKIP_GATE
#define SKIP_GATE 0
#endif
#ifndef SKIP_P0
#define SKIP_P0 0
#endif
#ifndef MK_PER_PHASE_LAUNCH
#define MK_PER_PHASE_LAUNCH 0
#endif

namespace pg8 {
#define PG8_LAS __attribute__((address_space(3)))
typedef unsigned short bf16_t;
typedef short bf16x8 __attribute__((ext_vector_type(8)));
typedef float f32x4 __attribute__((ext_vector_type(4)));
typedef float f32x2 __attribute__((ext_vector_type(2)));
typedef unsigned u32x4 __attribute__((ext_vector_type(4)));
constexpr int BM = 256, BK = 64, HALF = 128, HTB = HALF * BK * 2  , STAGE_BYTES = 8 * HTB, NXCD = 8, WGM = 8;

__host__ __device__ __forceinline__ int lds_byte(int r, int c) { const int st = (r >> 4) * 2 + (c >> 5), rr = r & 15, cc = c & 31, ob = rr * 64 + cc * 2; return st * 1024 + (ob ^ (((ob >> 9) & 1) << 5)); }
__host__ __device__ __forceinline__ void stage_rc(int b, int& R, int& C) { const int st = b / 1024, sb = b % 1024, swz = sb ^ (((sb >> 9) & 1) << 5); R = (st >> 1) * 16 + swz / 64; C = (st & 1) * 32 + (swz % 64) / 2; }
__host__ __device__ __forceinline__ int perm32(int rho) { const int n = rho >> 4, i = rho & 15; return 8 * (i >> 2) + 4 * n + (i & 3); }

struct Unit { int pm, pn; };
struct Gemm { const bf16_t* A; const bf16_t* Bt; int lda, ldb, M, N, K, a_kshift, a_kcols; };

struct StaticOrder {
    int nM, nN, nwg, G, c;
    __host__ __device__ void init(int M, int N, int G_, int c_) { nM = M / BM; nN = N / BM; nwg = nM * nN; G = G_; c = c_; }
    __host__ __device__ bool next(int i, Unit& u) const {
        const long L = (long)i * G + c; if (L >= nwg) return false;
        int wgid = (int)L; { const int q = nwg / NXCD, r = nwg % NXCD, xcd = wgid % NXCD, off = wgid / NXCD; wgid = (xcd < r ? xcd * (q + 1) : r * (q + 1) + (xcd - r) * q) + off; }
        const int nig = WGM * nN, gid = wgid / nig, fm = gid * WGM, gsz = (nM - fm) < WGM ? (nM - fm) : WGM;
        u.pm = fm + ((wgid % nig) % gsz); u.pn = (wgid % nig) / gsz; return true;
    }
    __device__ __forceinline__ void a_ready(const Unit&) const {}
    __device__ __forceinline__ void done(const Unit&) const {}
};

__device__ __forceinline__ unsigned cvt_pk_bf16(float lo, float hi) { unsigned r; asm volatile("v_cvt_pk_bf16_f32 %0, %1, %2" : "=v"(r) : "v"(lo), "v"(hi)); return r; }
__device__ __forceinline__ f32x2 gelu_pk(f32x2 v) {
    const f32x2 av = __builtin_elementwise_abs(v), d = av * 0.2316418882f + 1.0f;
    f32x2 t; t.x = __builtin_amdgcn_rcpf(d.x); t.y = __builtin_amdgcn_rcpf(d.y);
    f32x2 q = t * 0.5307027145f + (-0.7265760135f); q = q * t + 0.7107068705f; q = q * t + (-0.142248368f); q = q * t + 0.127414796f; q = q * t;
    const f32x2 s = (v * v) * (-0.72134752044f);
    f32x2 e; e.x = __builtin_amdgcn_exp2f(s.x); e.y = __builtin_amdgcn_exp2f(s.y);
    const f32x2 m = v * (q * e), r = v - m;
    f32x2 o; o.x = v.x < 0.f ? m.x : r.x; o.y = v.y < 0.f ? m.y : r.y; return o;
}
__device__ __forceinline__ f32x4 gelu4(f32x4 v) { const f32x2 a = gelu_pk((f32x2){v[0], v[1]}), b = gelu_pk((f32x2){v[2], v[3]}); return (f32x4){a.x, a.y, b.x, b.y}; }

template <int ACT> struct EpiBf16 {
    static constexpr bool PERM = true;
    bf16_t* O; int ldc; const float* cs;
    __device__ __forceinline__ void operator()(const f32x4 (&acc)[2][2][4][2], const Unit& u, int wr, int wc, int fr, int fq) const {
        const int row0 = u.pm * BM + wr * 64 + fr, col0 = u.pn * BM + wc * 32 + 8 * fq;
        f32x4 sv[2][2];
#pragma unroll
        for (int bj = 0; bj < 2; ++bj)
#pragma unroll
            for (int n = 0; n < 2; ++n) sv[bj][n] = (ACT == 3) ? *(const f32x4*)(cs + col0 + bj * HALF + 4 * n) : (f32x4){1.f, 1.f, 1.f, 1.f};
#pragma unroll
        for (int ai = 0; ai < 2; ++ai)
#pragma unroll
            for (int m = 0; m < 4; ++m) { bf16_t* rowp = O + (size_t)(row0 + ai * HALF + m * 16) * ldc + col0;
#pragma unroll
                for (int bj = 0; bj < 2; ++bj) { f32x4 v0 = acc[ai][bj][m][0], v1 = acc[ai][bj][m][1];
                    if (ACT == 1) { v0 = gelu4(v0); v1 = gelu4(v1); }
                    if (ACT == 2) { v0 = __builtin_elementwise_max(v0, (f32x4){0.f, 0.f, 0.f, 0.f}); v1 = __builtin_elementwise_max(v1, (f32x4){0.f, 0.f, 0.f, 0.f}); v0 = v0 * v0; v1 = v1 * v1; }
                    if (ACT == 3) { v0 = v0 * sv[bj][0]; v1 = v1 * sv[bj][1]; }
                    u32x4 w; w.x = cvt_pk_bf16(v0[0], v0[1]); w.y = cvt_pk_bf16(v0[2], v0[3]); w.z = cvt_pk_bf16(v1[0], v1[1]); w.w = cvt_pk_bf16(v1[2], v1[3]);
                    *(u32x4*)(rowp + bj * HALF) = w; } }
    }
};
struct EpiVT {
    static constexpr bool PERM = true;
    bf16_t* VT; int ldt; float* ssp;
    __device__ __forceinline__ void operator()(const f32x4 (&acc)[2][2][4][2], const Unit& u, int wr, int wc, int fr, int fq) const {
        const int row0 = u.pm * BM + wr * 64 + fr, col0 = u.pn * BM + wc * 32 + 8 * fq;
        f32x4 ss[2][2];
#pragma unroll
        for (int bj = 0; bj < 2; ++bj)
#pragma unroll
            for (int n = 0; n < 2; ++n) ss[bj][n] = (f32x4){0.f, 0.f, 0.f, 0.f};
#pragma unroll
        for (int ai = 0; ai < 2; ++ai)
#pragma unroll
            for (int m = 0; m < 4; ++m) { bf16_t* rowp = VT + (size_t)(row0 + ai * HALF + m * 16) * ldt + col0;
#pragma unroll
                for (int bj = 0; bj < 2; ++bj) { const f32x4 v0 = gelu4(acc[ai][bj][m][0]), v1 = gelu4(acc[ai][bj][m][1]);
                    ss[bj][0] += v0 * v0; ss[bj][1] += v1 * v1;
                    u32x4 w; w.x = cvt_pk_bf16(v0[0], v0[1]); w.y = cvt_pk_bf16(v0[2], v0[3]); w.z = cvt_pk_bf16(v1[0], v1[1]); w.w = cvt_pk_bf16(v1[2], v1[3]);
                    *(u32x4*)(rowp + bj * HALF) = w; } }
#pragma unroll
        for (int bj = 0; bj < 2; ++bj)
#pragma unroll
            for (int n = 0; n < 2; ++n)
#pragma unroll
                for (int j = 0; j < 4; ++j) { float s = ss[bj][n][j]; s += __shfl_xor(s, 1); s += __shfl_xor(s, 2); s += __shfl_xor(s, 4); s += __shfl_xor(s, 8); ss[bj][n][j] = s; }
        if (fr == 0) { float* p = ssp + (size_t)(u.pm * 2 + wr) * ldt + col0;
#pragma unroll
            for (int bj = 0; bj < 2; ++bj) { *(f32x4*)(p + bj * HALF) = ss[bj][0]; *(f32x4*)(p + bj * HALF + 4) = ss[bj][1]; } }
    }
};
struct EpiResid {
    static constexpr bool PERM = false;
    float* X; int ldc; const float* gate; int gstride;
    __device__ __forceinline__ void operator()(const f32x4 (&acc)[2][2][4][2], const Unit& u, int wr, int wc, int fr, int fq) const {
        const int row0 = u.pm * BM + wr * 64 + fr, col0 = u.pn * BM + wc * 32 + 4 * fq;
        const int b = u.pm < 32 ? 0 : (u.pm < 64 ? 1 : 2);
        const float* gp = gate + (size_t)b * gstride + col0;
        f32x4 gv[2][2];
#pragma unroll
        for (int bj = 0; bj < 2; ++bj)
#pragma unroll
            for (int n = 0; n < 2; ++n) gv[bj][n] = *(const f32x4*)(gp + bj * HALF + n * 16);
#pragma unroll
        for (int ai = 0; ai < 2; ++ai)
#pragma unroll
            for (int m = 0; m < 4; ++m) { float* rowp = X + (size_t)(row0 + ai * HALF + m * 16) * ldc + col0;
#pragma unroll
                for (int bj = 0; bj < 2; ++bj)
#pragma unroll
                    for (int n = 0; n < 2; ++n) { f32x4 x = *(const f32x4*)(rowp + bj * HALF + n * 16); x += gv[bj][n] * acc[ai][bj][m][n]; *(f32x4*)(rowp + bj * HALF + n * 16) = x; }
                asm volatile("" ::: "memory"); }
    }
};

template <class Epi, class Sched, bool ALIGN_EPI>
__device__ __forceinline__ void gemm_phase(PG8_LAS unsigned char* lds, const Gemm g, const Sched& S, const Epi& E) {
    int tid_ = threadIdx.x; asm volatile("" : "+v"(tid_));
    const int tid = tid_, wid = __builtin_amdgcn_readfirstlane(tid >> 6), lane = tid & 63, wr = wid >> 2, wc = wid & 3, fr = lane & 15, fq = lane >> 4;
    const int K = g.K, nt = K / BK;
    unsigned voffA[2], voffB[2];
#pragma unroll
    for (int i = 0; i < 2; ++i) { int R, C; stage_rc(tid * 16 + i * 8192, R, C); const int Rb = Epi::PERM ? ((R & ~31) + perm32(R & 31)) : R;
        voffA[i] = (unsigned)(R * g.lda + C) * 2u; voffB[i] = (unsigned)(Rb * g.ldb + C) * 2u; }
    const size_t kstep = (size_t)(BK * 2);
    const size_t hstepA = (size_t)HALF * g.lda * 2, hstepB = (size_t)HALF * g.ldb * 2;
    const size_t tstepA = 2 * hstepA, tstepB = 2 * hstepB;
    const unsigned ldsw = (unsigned)wid * 1024u;
    const int aoff = lds_byte(wr * 64 + fr, fq * 8), boff = lds_byte(wc * 32 + fr, fq * 8);
#define PG8_ABASE(u) ((const char*)g.A + (size_t)(u).pm * tstepA + (size_t)(((u).pn >> g.a_kshift) * g.a_kcols) * 2)
#define PG8_BBASE(u) ((const char*)g.Bt + (size_t)(u).pn * tstepB)
#define PG8_SA(b, h) (((b) * 2 + (h)) * HTB)
#define PG8_SB(b, h) ((4 + (b) * 2 + (h)) * HTB)
#define PG8_STAGE(bufoff, gbase, voff) do { _Pragma("unroll") for (int _i = 0; _i < 2; ++_i) \
        __builtin_amdgcn_global_load_lds((const unsigned*)((const char*)(gbase) + (voff)[_i]), (PG8_LAS unsigned*)(lds + (bufoff) + ldsw + _i * 8192), 16, 0, 0); } while (0)
#define PG8_LDA(dst, b, h) do { _Pragma("unroll") for (int m = 0; m < 4; ++m) _Pragma("unroll") for (int k = 0; k < 2; ++k) dst[m][k] = *(const PG8_LAS bf16x8*)(lds + PG8_SA(b, h) + aoff + m * 2048 + k * 1024); } while (0)
#define PG8_LDB(dst, b, h) do { _Pragma("unroll") for (int n = 0; n < 2; ++n) _Pragma("unroll") for (int k = 0; k < 2; ++k) dst[n][k] = *(const PG8_LAS bf16x8*)(lds + PG8_SB(b, h) + boff + n * 2048 + k * 1024); } while (0)
#define PG8_MMA(ai, bj, At, Bt) do { __builtin_amdgcn_s_setprio(1); _Pragma("unroll") for (int m = 0; m < 4; ++m) _Pragma("unroll") for (int n = 0; n < 2; ++n) _Pragma("unroll") for (int k = 0; k < 2; ++k) \
        acc[ai][bj][m][n] = __builtin_amdgcn_mfma_f32_16x16x32_bf16(Bt[n][k], At[m][k], acc[ai][bj][m][n], 0, 0, 0); __builtin_amdgcn_s_setprio(0); } while (0)
#define PG8_WAIT_V(n) asm volatile("s_waitcnt vmcnt(" #n ")" ::: "memory")
#define PG8_WAIT_L(n) asm volatile("s_waitcnt lgkmcnt(" #n ")" ::: "memory")
#define PG8_BAR __builtin_amdgcn_s_barrier()
#define PG8_SCHED __builtin_amdgcn_sched_barrier(0)
    Unit cur, nxt; int ui = 0;
    if (!S.next(0, cur)) return;
    f32x4 acc[2][2][4][2];
#pragma unroll
    for (int a = 0; a < 2; ++a)
#pragma unroll
        for (int b = 0; b < 2; ++b)
#pragma unroll
            for (int m = 0; m < 4; ++m)
#pragma unroll
                for (int n = 0; n < 2; ++n) acc[a][b][m][n] = (f32x4){0.f, 0.f, 0.f, 0.f};
    bf16x8 At[4][2], B0[2][2], B1[2][2];
    const char* cA = PG8_ABASE(cur); const char* cB = PG8_BBASE(cur);
    S.a_ready(cur);
    PG8_STAGE(PG8_SB(0, 0), cB, voffB); PG8_STAGE(PG8_SB(0, 1), cB + hstepB, voffB); PG8_STAGE(PG8_SA(0, 0), cA, voffA); PG8_STAGE(PG8_SA(0, 1), cA + hstepA, voffA);
    if (wr == 1) PG8_BAR;
    PG8_WAIT_V(2); PG8_BAR;
    PG8_STAGE(PG8_SB(1, 0), cB + kstep, voffB); PG8_STAGE(PG8_SA(1, 0), cA + kstep, voffA); PG8_STAGE(PG8_SB(1, 1), cB + hstepB + kstep, voffB);
    PG8_WAIT_V(6); PG8_BAR;
    for (;;) {
        const bool has_next = S.next(ui + 1, nxt);
        const char* nA = has_next ? PG8_ABASE(nxt) : cA; const char* nB = has_next ? PG8_BBASE(nxt) : cB;
        for (int t = 0; t < nt; t += 2) {
            const bool last = (t == nt - 2);
            const char* a1 = cA + (size_t)(t + 1) * kstep;
            const char* a2 = last ? nA : cA + (size_t)(t + 2) * kstep; const char* b2 = last ? nB : cB + (size_t)(t + 2) * kstep;
            const char* a3 = a2 + kstep; const char* b3 = b2 + kstep;
            if (last && has_next) S.a_ready(nxt);
            PG8_LDB(B0, 0, 0); PG8_LDB(B1, 0, 1); PG8_SCHED; PG8_LDA(At, 0, 0); PG8_STAGE(PG8_SA(1, 1), a1 + hstepA, voffA);
            PG8_WAIT_V(8); PG8_WAIT_L(0); PG8_BAR; PG8_MMA(0, 0, At, B0); PG8_MMA(0, 1, At, B1); PG8_BAR; PG8_SCHED;
            PG8_LDA(At, 0, 1); PG8_STAGE(PG8_SB(0, 0), b2, voffB); PG8_STAGE(PG8_SB(0, 1), b2 + hstepB, voffB); PG8_STAGE(PG8_SA(0, 0), a2, voffA);
            PG8_WAIT_V(8); PG8_WAIT_L(0); PG8_BAR; PG8_MMA(1, 0, At, B0); PG8_MMA(1, 1, At, B1); PG8_BAR; PG8_SCHED;
            PG8_LDB(B0, 1, 0); PG8_LDB(B1, 1, 1); PG8_SCHED; PG8_LDA(At, 1, 0); PG8_STAGE(PG8_SA(0, 1), a2 + hstepA, voffA);
            PG8_WAIT_V(8); PG8_WAIT_L(0); PG8_BAR; PG8_MMA(0, 0, At, B0); PG8_MMA(0, 1, At, B1); PG8_BAR; PG8_SCHED;
            PG8_LDA(At, 1, 1); PG8_STAGE(PG8_SB(1, 0), b3, voffB); PG8_STAGE(PG8_SB(1, 1), b3 + hstepB, voffB); PG8_STAGE(PG8_SA(1, 0), a3, voffA);
            PG8_WAIT_V(8); PG8_WAIT_L(0); PG8_BAR; PG8_MMA(1, 0, At, B0); PG8_MMA(1, 1, At, B1); PG8_BAR; PG8_SCHED;
        }
        if constexpr (ALIGN_EPI) { if (wr == 0) PG8_BAR; }
        E(acc, cur, wr, wc, fr, fq); S.done(cur);
        if (!has_next) break;
#pragma unroll
        for (int a = 0; a < 2; ++a)
#pragma unroll
            for (int b = 0; b < 2; ++b)
#pragma unroll
                for (int m = 0; m < 4; ++m)
#pragma unroll
                    for (int n = 0; n < 2; ++n) acc[a][b][m][n] = (f32x4){0.f, 0.f, 0.f, 0.f};
        cur = nxt; cA = nA; cB = nB; ++ui;
        if constexpr (ALIGN_EPI) { if (wr == 1) PG8_BAR; }
    }
    PG8_WAIT_V(0);
    if constexpr (!ALIGN_EPI) { if (wr == 0) PG8_BAR; }
    PG8_BAR;
#undef PG8_ABASE
#undef PG8_BBASE
#undef PG8_SA
#undef PG8_SB
#undef PG8_STAGE
#undef PG8_LDA
#undef PG8_LDB
#undef PG8_MMA
#undef PG8_WAIT_V
#undef PG8_WAIT_L
#undef PG8_BAR
#undef PG8_SCHED
}
}

constexpr int NWAVES = 8;
constexpr int D = 2048, T = 32768, DEPTH = 4, NBATCH = 3;
constexpr int FF = 8192, SFF = 12288, SHALF = 6144, NHEADS = 8, HDIM = 768, CHUNK = 128, NMOD = 6, PGRP = 512;
constexpr int NSSP = 48;
constexpr float EPS = 1e-6f;

constexpr size_t MiB = 1u << 20;
constexpr size_t WS_CTL = 0, CTL_ZERO_BYTES = 1 * MiB;
constexpr size_t WS_MODV = 1 * MiB;
constexpr size_t WS_SSP = 2 * MiB;
constexpr size_t WS_WPIN = 8 * MiB;
constexpr size_t WS_WPGRP = 24 * MiB;
constexpr size_t WS_WPOUT = 28 * MiB;
constexpr size_t WS_WSIN = 44 * MiB;
constexpr size_t WS_WSOUT = 140 * MiB;
constexpr size_t WS_W1 = 188 * MiB;
constexpr size_t WS_W2 = 316 * MiB;
constexpr size_t WS_H = 444 * MiB;
constexpr size_t WS_BIG = 572 * MiB;
constexpr size_t WS_END = 1340 * MiB;
constexpr int CW_BAR = 4096;

#define LAS __attribute__((address_space(3)))
typedef unsigned short bf16;
typedef unsigned v4u __attribute__((ext_vector_type(4)));
typedef unsigned v2u __attribute__((ext_vector_type(2)));
typedef float f32x4 __attribute__((ext_vector_type(4)));
typedef short bf16x8 __attribute__((ext_vector_type(8)));
#define LDS_WAIT() asm volatile("s_waitcnt lgkmcnt(0)" ::: "memory")
__device__ __forceinline__ unsigned f2bf(float f) { unsigned u = __builtin_bit_cast(unsigned, f); return (u + 0x7fffu + ((u >> 16) & 1u)) >> 16; }
__device__ __forceinline__ unsigned pk2(float lo, float hi) { return f2bf(lo) | (f2bf(hi) << 16); }
__device__ __forceinline__ float bflo(unsigned w) { return __builtin_bit_cast(float, w << 16); }
__device__ __forceinline__ float bfhi(unsigned w) { return __builtin_bit_cast(float, w & 0xffff0000u); }

#define XB_TMO      128
#define XB_XCNT(j)  (256  + 64 * (j))
#define XB_XSUB(j)  (1280 + 64 * (j))
#define XB_XGEN(j)  (2304 + 64 * (j))
#define XB_TOP      3328
#define XB_TOPGEN   3392
#define XCD_BAR_WORDS 3456
#define XB_SPIN_CAP (1u << 18)

__device__ __forceinline__ unsigned xb_ld(unsigned* p)              { return __hip_atomic_load(p, __ATOMIC_RELAXED, __HIP_MEMORY_SCOPE_AGENT); }
__device__ __forceinline__ unsigned xb_add(unsigned* p, unsigned v) { return __hip_atomic_fetch_add(p, v, __ATOMIC_RELAXED, __HIP_MEMORY_SCOPE_AGENT); }
__device__ __forceinline__ unsigned xb_xcc_id() { return (unsigned)__builtin_amdgcn_s_getreg((3 << 11) | 20) & 0xFu; }
#define XB_SPIN(cond, bar) do { unsigned _sp = 0; while (cond) { __builtin_amdgcn_s_sleep(1); \
    if ((++_sp & 255u) == 0u) { if (xb_ld(&(bar)[XB_TMO])) break; if (_sp > XB_SPIN_CAP) { atomicAdd(&(bar)[XB_TMO], 1u); break; } } } } while (0)

struct XcdBarrier {
    unsigned* bar; unsigned x;
    volatile LAS unsigned* st;
};
__device__ __forceinline__ XcdBarrier xcd_barrier_post(unsigned* bar, volatile LAS unsigned* st) {
    XcdBarrier b; b.bar = bar; b.x = xb_xcc_id(); b.st = st;
    if (threadIdx.x == 0) (void)xb_add(&bar[XB_XCNT(b.x)], 1u);
    return b;
}
__device__ __forceinline__ void xcd_barrier_complete(unsigned* bar, unsigned x, unsigned& nloc, unsigned& nx) {
    const unsigned G = gridDim.x * gridDim.y * gridDim.z;
    unsigned sum, cnt, mine, sp = 0u;
    for (;;) {
        sum = 0u; cnt = 0u; mine = 0u;
#pragma unroll
        for (unsigned j = 0; j < 16; ++j) { const unsigned c = xb_ld(&bar[XB_XCNT(j)]); sum += c; cnt += (c > 0u) ? 1u : 0u; mine = (j == x) ? c : mine; }
        if (sum == G) break;
        __builtin_amdgcn_s_sleep(1);
        if ((++sp & 255u) == 0u) { if (xb_ld(&bar[XB_TMO])) break; if (sp > XB_SPIN_CAP) { atomicAdd(&bar[XB_TMO], 1u); break; } }
    }
    nloc = mine > 0u ? mine : 1u; nx = cnt > 0u ? cnt : 1u;
}
__device__ __forceinline__ void xcd_barrier(const XcdBarrier& b) {
    asm volatile("s_waitcnt vmcnt(0)" ::: "memory");
    __syncthreads();
    if (threadIdx.x == 0) {
        unsigned* bar = b.bar; asm volatile("" : "+s"(bar));
        __builtin_amdgcn_s_waitcnt(0);
        unsigned nloc = b.st[0], nx = b.st[1];
        if (nloc == 0u) { xcd_barrier_complete(bar, b.x, nloc, nx); b.st[0] = nloc; b.st[1] = nx; }
        const unsigned old = xb_add(&bar[XB_XSUB(b.x)], 1u);
        const unsigned gen = old / nloc;
        if (old + 1u == (gen + 1u) * nloc) {
            __builtin_amdgcn_fence(__ATOMIC_RELEASE, "agent");
            asm volatile("s_waitcnt vmcnt(0)" ::: "memory");
            const unsigned og = xb_add(&bar[XB_TOP], 1u);
            const unsigned tg = og / nx;
            if (og + 1u == (tg + 1u) * nx) xb_add(&bar[XB_TOPGEN], 1u);
            else XB_SPIN(xb_ld(&bar[XB_TOPGEN]) == tg, bar);
            __builtin_amdgcn_fence(__ATOMIC_ACQUIRE, "agent");
            xb_add(&bar[XB_XGEN(b.x)], 1u);
            asm volatile("s_waitcnt vmcnt(0)" ::: "memory");
        } else {
            XB_SPIN(xb_ld(&bar[XB_XGEN(b.x)]) == gen, bar);
            __builtin_amdgcn_fence(__ATOMIC_ACQUIRE, "agent");
            asm volatile("s_waitcnt vmcnt(0)" ::: "memory");
        }
    }
    __syncthreads();
}

constexpr int RING_OFF = 0, RING_BYTES = 131072;
constexpr int MISC_OFF = RING_BYTES;
constexpr int LDS_BYTES = 147456;

__device__ __forceinline__ int otid() { int t = threadIdx.x; asm volatile("" : "+v"(t)); return t; }
__device__ __forceinline__ float wave_sum(float v) {
#pragma unroll
    for (int o = 1; o < 64; o <<= 1) v += __shfl_xor(v, o);
    return v;
}

__device__ __forceinline__ void p0_transpose_item(const float* W, int K, int N, bf16* WT, LAS float* scr, int item, int lane) {
    const int nblk = N / 32, kb = item / nblk, nb = item % nblk, k0 = 64 * kb, n0 = 32 * nb;
#pragma unroll 8
    for (int i = 0; i < 32; ++i) { const int kk = 2 * i + (lane >> 5); scr[kk * 33 + (lane & 31)] = W[(size_t)(k0 + kk) * N + n0 + (lane & 31)]; }
    LDS_WAIT(); asm volatile("" ::: "memory");
    const int c = lane & 7;
#pragma unroll
    for (int j = 0; j < 4; ++j) { const int n = (lane >> 3) + 8 * j; const LAS float* s = scr + (8 * c) * 33 + n;
        v4u o; o.x = pk2(s[0 * 33], s[1 * 33]); o.y = pk2(s[2 * 33], s[3 * 33]); o.z = pk2(s[4 * 33], s[5 * 33]); o.w = pk2(s[6 * 33], s[7 * 33]);
        *(v4u*)(WT + (size_t)(n0 + n) * K + k0 + 8 * c) = o; }
    LDS_WAIT(); asm volatile("" ::: "memory");
}
__device__ __forceinline__ bool p0_stack(int& it, const float* W, int L, int K, int N, bf16* WT, LAS float* scr, int lane) {
    const int per = (K / 64) * (N / 32), tot = L * per;
    if (it >= tot) { it -= tot; return false; }
    const int l = it / per, r = it % per;
    p0_transpose_item(W + (size_t)l * K * N, K, N, WT + (size_t)l * K * N, scr, r, lane);
    return true;
}

struct Args {
    const float* in[20]; float* out; unsigned char* ws; int ph_lo, ph_hi;
};

__global__ void __launch_bounds__(NWAVES * 64, 2) enc_fwd(Args args) {
    extern __shared__ __attribute__((aligned(16))) unsigned char lds_raw[];
    LAS unsigned char* lds = (LAS unsigned char*)lds_raw;
    volatile LAS unsigned* MISC = (volatile LAS unsigned*)(lds + MISC_OFF);
    const int tid = threadIdx.x, lane = tid & 63, wave = __builtin_amdgcn_readfirstlane(tid >> 6);
    const int G = gridDim.x, bx = blockIdx.x;
    unsigned char* ws = args.ws;
    unsigned* ctl = (unsigned*)(ws + WS_CTL);
    float* X = args.out;
    float* MODV = (float*)(ws + WS_MODV);
    float* SSP = (float*)(ws + WS_SSP);
    bf16* Hb = (bf16*)(ws + WS_H);
    bf16* BIG = (bf16*)(ws + WS_BIG);

    for (int u = tid; u < 32; u += NWAVES * 64) ((LAS unsigned*)(lds + MISC_OFF))[u] = 0u;
    __syncthreads();
#if MK_PER_PHASE_LAUNCH
#define GRID_BAR() do { } while (0)
#else
    XcdBarrier bar = xcd_barrier_post(ctl + CW_BAR, MISC + 8);
#define GRID_BAR() xcd_barrier(bar)
#endif
#if MK_PER_PHASE_LAUNCH
    const int lo = args.ph_lo;
#define IN(k) (lo == (k))
#else
#define IN(k) true
#endif
#define SEAM(k) do { if (IN(k) && IN((k) + 1)) GRID_BAR(); } while (0)

    if (IN(0) && !SKIP_P0) {
        LAS float* cact = (LAS float*)(lds + RING_OFF);
        LAS float* red = (LAS float*)(lds + RING_OFF + 32768);
        for (int u = tid; u < NBATCH * D; u += NWAVES * 64) { const int b = u / D, d = u % D; const float c = (b < 2) ? args.in[2][b * D + d] : args.in[3][d]; cact[u] = c / (1.0f + __expf(-c)); }
        __syncthreads();
        const float* mod_w = args.in[6]; const float* mod_b = args.in[7];
        for (int item = bx; item < DEPTH * (NMOD * D / 64); item += G) {
            const int i = item / (NMOD * D / 64), e0 = (item % (NMOD * D / 64)) * 64;
            const int r4 = lane >> 4, c4 = (lane & 15) * 4;
            const float* wp = mod_w + (size_t)i * D * (NMOD * D) + (size_t)(wave * 256 + r4) * (NMOD * D) + e0 + c4;
            f32x4 a0 = {0.f, 0.f, 0.f, 0.f}, a1 = a0, a2 = a0;
#pragma unroll 8
            for (int it = 0; it < 64; ++it) { const f32x4 w = *(const f32x4*)(wp + (size_t)it * 4 * (NMOD * D)); const int d = wave * 256 + it * 4 + r4;
                a0 += w * cact[d]; a1 += w * cact[D + d]; a2 += w * cact[2 * D + d]; }
#pragma unroll
            for (int j = 0; j < 4; ++j) { a0[j] += __shfl_xor(a0[j], 16); a0[j] += __shfl_xor(a0[j], 32); a1[j] += __shfl_xor(a1[j], 16); a1[j] += __shfl_xor(a1[j], 32); a2[j] += __shfl_xor(a2[j], 16); a2[j] += __shfl_xor(a2[j], 32); }
            if (lane < 16) { *(LAS f32x4*)(red + (wave * 3 + 0) * 64 + c4) = a0; *(LAS f32x4*)(red + (wave * 3 + 1) * 64 + c4) = a1; *(LAS f32x4*)(red + (wave * 3 + 2) * 64 + c4) = a2; }
            __syncthreads();
            if (tid < 192) { const int b = tid / 64, c = tid % 64; float s = mod_b[(size_t)i * (NMOD * D) + e0 + c];
#pragma unroll
                for (int w = 0; w < 8; ++w) s += red[(w * 3 + b) * 64 + c];
                MODV[((size_t)i * NBATCH + b) * (NMOD * D) + e0 + c] = s; }
            __syncthreads();
        }
        LAS float* scr = (LAS float*)(lds + RING_OFF + wave * 16384);
        const int gw = bx * NWAVES + wave, NGW = G * NWAVES;
        constexpr int NITEMS = 2 * (D / 64) * (D / 32) * 2 + 8 * (PGRP / 64) * (PGRP / 32) + 2 * (D / 64) * (SFF / 32) + 2 * (SHALF / 64) * (D / 32) + 4 * (D / 64) * (FF / 32) + 4 * (FF / 64) * (D / 32);
        for (int it0 = gw; it0 < NITEMS; it0 += NGW) {
            int it = it0;
            if (p0_stack(it, args.in[17], 4, D, FF, (bf16*)(ws + WS_W1), scr, lane)) continue;
            if (p0_stack(it, args.in[18], 4, FF, D, (bf16*)(ws + WS_W2), scr, lane)) continue;
            if (p0_stack(it, args.in[12], 2, D, SFF, (bf16*)(ws + WS_WSIN), scr, lane)) continue;
            if (p0_stack(it, args.in[16], 2, SHALF, D, (bf16*)(ws + WS_WSOUT), scr, lane)) continue;
            if (p0_stack(it, args.in[8], 2, D, D, (bf16*)(ws + WS_WPIN), scr, lane)) continue;
            if (p0_stack(it, args.in[11], 2, D, D, (bf16*)(ws + WS_WPOUT), scr, lane)) continue;
            p0_stack(it, args.in[9], 8, PGRP, PGRP, (bf16*)(ws + WS_WPGRP), scr, lane);
        }
        __syncthreads();
    }
    SEAM(0);

    for (int i = 0; i < DEPTH; ++i) {
        const int j = i >> 1, pb = 1 + i * 8;
        const float* modl = MODV + (size_t)i * NBATCH * (NMOD * D);
#define NORM_PHASE(sub) do { \
            const int tid = otid(), lane = tid & 63, wave = __builtin_amdgcn_readfirstlane(tid >> 6); \
            LAS float* gs = (LAS float*)(lds + RING_OFF); LAS float* shv = gs + D; \
            const float* gvec = args.in[(sub) ? 5 : 4] + (size_t)i * D; \
            for (int rb = bx; rb < T / 128; rb += G) { \
                const int r0 = rb * 128, b = r0 < 8192 ? 0 : (r0 < 16384 ? 1 : 2); \
                const float* mb = modl + (size_t)b * (NMOD * D) + (sub) * 3 * D; \
                { const int c = tid * 4; const f32x4 gq = *(const f32x4*)(gvec + c), sc = *(const f32x4*)(mb + D + c), sh = *(const f32x4*)(mb + c); \
                  *(LAS f32x4*)(gs + c) = gq * (sc + 1.0f); *(LAS f32x4*)(shv + c) = sh; } \
                __syncthreads(); \
                for (int rr = 0; rr < 16; ++rr) { const int row = r0 + wave * 16 + rr; \
                    const float* src = (i == 0 && (sub) == 0) ? (row < 16384 ? args.in[0] + (size_t)row * D : args.in[1] + (size_t)(row - 16384) * D) : X + (size_t)row * D; \
                    f32x4 v[8]; float ss = 0.f; \
                    _Pragma("unroll") for (int q = 0; q < 8; ++q) { v[q] = *(const f32x4*)(src + q * 256 + lane * 4); } \
                    _Pragma("unroll") for (int q = 0; q < 8; ++q) { ss += (v[q][0] * v[q][0] + v[q][1] * v[q][1]) + (v[q][2] * v[q][2] + v[q][3] * v[q][3]); } \
                    const float rinv = 1.0f / sqrtf(wave_sum(ss) * (1.0f / D) + EPS); \
                    if (i == 0 && (sub) == 0) { _Pragma("unroll") for (int q = 0; q < 8; ++q) *(f32x4*)(X + (size_t)row * D + q * 256 + lane * 4) = v[q]; } \
                    _Pragma("unroll") for (int q = 0; q < 8; ++q) { const f32x4 g4 = *(const LAS f32x4*)(gs + q * 256 + lane * 4), s4 = *(const LAS f32x4*)(shv + q * 256 + lane * 4); \
                        const f32x4 o = v[q] * rinv * g4 + s4; v2u w; w.x = pk2(o[0], o[1]); w.y = pk2(o[2], o[3]); *(v2u*)(Hb + (size_t)row * D + q * 256 + lane * 4) = w; } } \
                __syncthreads(); } } while (0)

        if (IN(pb + 0) && !SKIP_NORM) NORM_PHASE(0);
        SEAM(pb + 0);

        if ((i & 1) == 0) {
            bf16* Z = BIG; bf16* ZD = BIG + (size_t)T * D; bf16* Y = BIG + 2 * (size_t)T * D;
            if (IN(pb + 1)) {
                pg8::Gemm g{Hb, (const bf16*)(ws + WS_WPIN) + (size_t)j * D * D, D, D, T, D, D, 0, 0}; pg8::StaticOrder S; S.init(T, D, G, bx);
                pg8::EpiBf16<0> E{Z, D, nullptr};
                pg8::gemm_phase<pg8::EpiBf16<0>, pg8::StaticOrder, true>(lds + RING_OFF, g, S, E);
            }
            SEAM(pb + 1);
            if (IN(pb + 2) && !SKIP_POOL) {
                const int tid = otid();
                for (int seg = bx; seg < T / 128; seg += G) {
                    const int half = tid >> 8, chunk = tid & 255, gsel = chunk >> 6, hw = 1 << gsel;
                    const int r0 = seg * 128 + half * 64;
                    const int s0 = r0 < 8192 ? 0 : (r0 < 16384 ? 8192 : 16384), s1 = r0 < 8192 ? 8192 : (r0 < 16384 ? 16384 : 32768);
                    const bf16* zc = Z + chunk * 8; bf16* oc = ZD + chunk * 8;
                    float sum[8];
#pragma unroll
                    for (int q = 0; q < 8; ++q) sum[q] = 0.f;
                    for (int t = r0 - hw; t <= r0 + hw - 1; ++t) if (t >= s0 && t < s1) { const v4u w = *(const v4u*)(zc + (size_t)t * D);
                        sum[0] += bflo(w.x); sum[1] += bfhi(w.x); sum[2] += bflo(w.y); sum[3] += bfhi(w.y); sum[4] += bflo(w.z); sum[5] += bfhi(w.z); sum[6] += bflo(w.w); sum[7] += bfhi(w.w); }
#pragma unroll 4
                    for (int t = r0; t < r0 + 64; ++t) {
                        const int lo_t = (t - hw > s0) ? t - hw : s0, hi_t = (t + hw - 1 < s1 - 1) ? t + hw - 1 : s1 - 1;
                        const float inv = 1.0f / (float)(hi_t - lo_t + 1);
                        const v4u zc4 = *(const v4u*)(zc + (size_t)t * D);
                        v4u add = {0u, 0u, 0u, 0u}, sub = {0u, 0u, 0u, 0u};
                        if (t + hw < s1) add = *(const v4u*)(zc + (size_t)(t + hw) * D);
                        if (t - hw >= s0) sub = *(const v4u*)(zc + (size_t)(t - hw) * D);
                        v4u o;
                        o.x = pk2(sum[0] * inv - bflo(zc4.x), sum[1] * inv - bfhi(zc4.x)); o.y = pk2(sum[2] * inv - bflo(zc4.y), sum[3] * inv - bfhi(zc4.y));
                        o.z = pk2(sum[4] * inv - bflo(zc4.z), sum[5] * inv - bfhi(zc4.z)); o.w = pk2(sum[6] * inv - bflo(zc4.w), sum[7] * inv - bfhi(zc4.w));
                        *(v4u*)(oc + (size_t)t * D) = o;
                        sum[0] += bflo(add.x) - bflo(sub.x); sum[1] += bfhi(add.x) - bfhi(sub.x); sum[2] += bflo(add.y) - bflo(sub.y); sum[3] += bfhi(add.y) - bfhi(sub.y);
                        sum[4] += bflo(add.z) - bflo(sub.z); sum[5] += bfhi(add.z) - bfhi(sub.z); sum[6] += bflo(add.w) - bflo(sub.w); sum[7] += bfhi(add.w) - bfhi(sub.w);
                    }
                }
            }
            SEAM(pb + 2);
            if (IN(pb + 3)) {
                pg8::Gemm g{ZD, (const bf16*)(ws + WS_WPGRP) + (size_t)j * D * PGRP, D, PGRP, T, D, PGRP, 1, PGRP}; pg8::StaticOrder S; S.init(T, D, G, bx);
                pg8::EpiBf16<3> E{Y, D, args.in[10] + (size_t)j * D};
                pg8::gemm_phase<pg8::EpiBf16<3>, pg8::StaticOrder, true>(lds + RING_OFF, g, S, E);
            }
            SEAM(pb + 3);
            if (IN(pb + 4)) {
                pg8::Gemm g{Y, (const bf16*)(ws + WS_WPOUT) + (size_t)j * D * D, D, D, T, D, D, 0, 0}; pg8::StaticOrder S; S.init(T, D, G, bx);
                pg8::EpiResid E{X, D, modl + 2 * D, NMOD * D};
                pg8::gemm_phase<pg8::EpiResid, pg8::StaticOrder, true>(lds + RING_OFF, g, S, E);
            }
            SEAM(pb + 4);
        } else {
            bf16* U = BIG; bf16* VT = BIG + (size_t)T * SHALF;
            const bf16* wsin = (const bf16*)(ws + WS_WSIN) + (size_t)j * SFF * D;
            if (IN(pb + 1)) {
                {
                    pg8::Gemm g{Hb, wsin, D, D, T, SHALF, D, 0, 0}; pg8::StaticOrder S; S.init(T, SHALF, G, bx);
                    pg8::EpiBf16<1> E{U, SHALF, nullptr};
                    pg8::gemm_phase<pg8::EpiBf16<1>, pg8::StaticOrder, true>(lds + RING_OFF, g, S, E);
                }
                {
                    pg8::Gemm g{wsin + (size_t)SHALF * D, Hb, D, D, SHALF, T, D, 0, 0}; pg8::StaticOrder S; S.init(SHALF, T, G, bx);
                    pg8::EpiVT E{VT, T, SSP};
                    pg8::gemm_phase<pg8::EpiVT, pg8::StaticOrder, true>(lds + RING_OFF, g, S, E);
                }
            }
            SEAM(pb + 1);
            if (IN(pb + 2) && !SKIP_GATE) {
                LAS unsigned char* Wl = lds + RING_OFF;
                LAS float* rinv = (LAS float*)(lds + RING_OFF + 32768);
                const float* w_s = args.in[14] + (size_t)j * NHEADS * CHUNK * CHUNK; const float* b_s = args.in[15] + (size_t)j * NHEADS * CHUNK; const float* gain = args.in[13] + (size_t)j * SHALF;
                const int tid = otid(), lane = tid & 63, wave = __builtin_amdgcn_readfirstlane(tid >> 6);
                const int fr = lane & 15, fq = lane >> 4;
                for (int item = bx; item < (T / CHUNK) * NHEADS; item += G) {
                    const int n = item >> 3, h = item & 7, t0 = n * CHUNK;
                    if (tid < CHUNK) { float s = 0.f;
#pragma unroll 8
                        for (int k = 0; k < NSSP; ++k) s += SSP[(size_t)k * T + t0 + tid];
                        rinv[tid] = 1.0f / sqrtf(s * (1.0f / SHALF) + EPS); }
                    __syncthreads();
#pragma unroll
                    for (int it = 0; it < 8; ++it) { const int e = (it * 512 + tid) * 4, p = e >> 7, q = e & 127;
                        const f32x4 w = *(const f32x4*)(w_s + (size_t)h * CHUNK * CHUNK + e) * *(const LAS f32x4*)(rinv + q);
                        v2u o; o.x = pk2(w[0], w[1]); o.y = pk2(w[2], w[3]);
                        *(LAS v2u*)(Wl + p * 256 + (((q >> 3) ^ (p & 15)) << 4) + (q & 7) * 2) = o; }
                    __syncthreads();
#pragma unroll 1
                    for (int pass = 0; pass < 3; ++pass) {
                        const int cbase = h * HDIM + wave * 96 + pass * 32;
                        bf16x8 va[2][4];
#pragma unroll
                        for (int j2 = 0; j2 < 2; ++j2)
#pragma unroll
                            for (int kb = 0; kb < 4; ++kb) va[j2][kb] = *(const bf16x8*)(VT + (size_t)(cbase + 8 * (fr >> 2) + 4 * j2 + (fr & 3)) * T + t0 + kb * 32 + fq * 8);
                        const f32x4 g0 = *(const f32x4*)(gain + cbase + 8 * fq), g1 = *(const f32x4*)(gain + cbase + 8 * fq + 4);
#pragma unroll 1
                        for (int hf = 0; hf < 2; ++hf) {
                            bf16* up = U + (size_t)(t0 + hf * 64 + fr) * SHALF + cbase + 8 * fq;
                            v4u uu[4]; f32x4 acc[2][4];
#pragma unroll
                            for (int pk = 0; pk < 4; ++pk) { uu[pk] = *(const v4u*)(up + (size_t)pk * 16 * SHALF); acc[0][pk] = (f32x4){0.f, 0.f, 0.f, 0.f}; acc[1][pk] = (f32x4){0.f, 0.f, 0.f, 0.f}; }
#pragma unroll
                            for (int pk = 0; pk < 4; ++pk) {
                                bf16x8 wb[4]; const int p = hf * 64 + pk * 16 + fr;
#pragma unroll
                                for (int kb = 0; kb < 4; ++kb) wb[kb] = *(const LAS bf16x8*)(Wl + p * 256 + (((kb * 4 + fq) ^ fr) << 4));
#pragma unroll
                                for (int kb = 0; kb < 4; ++kb) { acc[0][pk] = __builtin_amdgcn_mfma_f32_16x16x32_bf16(va[0][kb], wb[kb], acc[0][pk], 0, 0, 0);
                                                                 acc[1][pk] = __builtin_amdgcn_mfma_f32_16x16x32_bf16(va[1][kb], wb[kb], acc[1][pk], 0, 0, 0); }
                            }
#pragma unroll
                            for (int pk = 0; pk < 4; ++pk) { const v4u u4 = uu[pk]; const float bsv = b_s[h * CHUNK + hf * 64 + pk * 16 + fr]; const f32x4 m0 = acc[0][pk] * g0 + bsv, m1 = acc[1][pk] * g1 + bsv;
                                v4u o; o.x = pk2(bflo(u4.x) * m0[0], bfhi(u4.x) * m0[1]); o.y = pk2(bflo(u4.y) * m0[2], bfhi(u4.y) * m0[3]);
                                o.z = pk2(bflo(u4.z) * m1[0], bfhi(u4.z) * m1[1]); o.w = pk2(bflo(u4.w) * m1[2], bfhi(u4.w) * m1[3]);
                                *(v4u*)(up + (size_t)pk * 16 * SHALF) = o; }
                        }
                    }
                    __syncthreads();
                }
            }
            if (IN(pb + 2) && IN(pb + 4)) GRID_BAR();
            if (IN(pb + 4)) {
                pg8::Gemm g{U, (const bf16*)(ws + WS_WSOUT) + (size_t)j * D * SHALF, SHALF, SHALF, T, D, SHALF, 0, 0}; pg8::StaticOrder S; S.init(T, D, G, bx);
                pg8::EpiResid E{X, D, modl + 2 * D, NMOD * D};
                pg8::gemm_phase<pg8::EpiResid, pg8::StaticOrder, true>(lds + RING_OFF, g, S, E);
            }
            SEAM(pb + 4);
        }

        if (IN(pb + 5) && !SKIP_NORM) NORM_PHASE(1);
        SEAM(pb + 5);
        bf16* A2 = BIG;
        if (IN(pb + 6)) {
            pg8::Gemm g{Hb, (const bf16*)(ws + WS_W1) + (size_t)i * FF * D, D, D, T, FF, D, 0, 0}; pg8::StaticOrder S; S.init(T, FF, G, bx);
            pg8::EpiBf16<2> E{A2, FF, nullptr};
            pg8::gemm_phase<pg8::EpiBf16<2>, pg8::StaticOrder, true>(lds + RING_OFF, g, S, E);
        }
        SEAM(pb + 6);
        if (IN(pb + 7)) {
            pg8::Gemm g{A2, (const bf16*)(ws + WS_W2) + (size_t)i * D * FF, FF, FF, T, D, FF, 0, 0}; pg8::StaticOrder S; S.init(T, D, G, bx);
            pg8::EpiResid E{X, D, modl + 5 * D, NMOD * D};
            pg8::gemm_phase<pg8::EpiResid, pg8::StaticOrder, true>(lds + RING_OFF, g, S, E);
        }
        SEAM(pb + 7);
    }

    if (IN(1 + DEPTH * 8)) {
        const float* fg = args.in[19];
        const int gw = bx * NWAVES + wave, NGW = G * NWAVES;
        for (int row = gw; row < T; row += NGW) {
            float* xr = X + (size_t)row * D;
            f32x4 v[8]; float ss = 0.f;
#pragma unroll
            for (int q = 0; q < 8; ++q) v[q] = *(const f32x4*)(xr + q * 256 + lane * 4);
#pragma unroll
            for (int q = 0; q < 8; ++q) ss += (v[q][0] * v[q][0] + v[q][1] * v[q][1]) + (v[q][2] * v[q][2] + v[q][3] * v[q][3]);
            const float rinv = 1.0f / sqrtf(wave_sum(ss) * (1.0f / D) + EPS);
#pragma unroll
            for (int q = 0; q < 8; ++q) { const f32x4 g4 = *(const f32x4*)(fg + q * 256 + lane * 4); *(f32x4*)(xr + q * 256 + lane * 4) = v[q] * rinv * g4; }
        }
    }
#undef IN
#undef SEAM
#undef NORM_PHASE
}

extern "C" void kernel_launch(void* const* d_in, const int* in_sizes, int n_in, void* d_out, int out_size, void* d_ws, size_t ws_size, hipStream_t stream) {
    static int grid = 0;
    if (grid == 0) {
        if (n_in != 20 || out_size != T * D || ws_size < WS_END) { fprintf(stderr, "kernel_launch: built for 20 inputs, out of %d floats, >= %zu bytes of workspace; got n_in %d, out %d, ws %zu; nothing launched\n", T * D, (size_t)WS_END, n_in, out_size, ws_size); grid = -1; return; }
        int dev = 0, cus = 0, per_cu = 0;
        if (hipGetDevice(&dev) != hipSuccess || hipDeviceGetAttribute(&cus, hipDeviceAttributeMultiprocessorCount, dev) != hipSuccess) { fprintf(stderr, "kernel_launch: hipGetDevice / hipDeviceGetAttribute failed\n"); grid = -1; return; }
        if (hipFuncSetAttribute((const void*)enc_fwd, hipFuncAttributeMaxDynamicSharedMemorySize, LDS_BYTES) != hipSuccess) { fprintf(stderr, "kernel_launch: hipFuncSetAttribute failed\n"); grid = -1; return; }
        if (hipOccupancyMaxActiveBlocksPerMultiprocessor(&per_cu, (const void*)enc_fwd, NWAVES * 64, LDS_BYTES) != hipSuccess || per_cu < 1) { fprintf(stderr, "kernel_launch: occupancy query reports %d workgroups per CU\n", per_cu); }
        (void)hipGetLastError();
        grid = cus;
    }
    if (grid < 0) return;
    if (hipMemsetAsync((char*)d_ws + WS_CTL, 0, CTL_ZERO_BYTES, stream) != hipSuccess) { fprintf(stderr, "kernel_launch: hipMemsetAsync failed\n"); return; }
    Args a{};
    for (int i = 0; i < 20; ++i) a.in[i] = (const float*)d_in[i];
    a.out = (float*)d_out; a.ws = (unsigned char*)d_ws;
    constexpr int NPH = 2 + DEPTH * 8;
#if MK_PER_PHASE_LAUNCH
    for (int p = 0; p < NPH; ++p) { a.ph_lo = p; a.ph_hi = p + 1; hipLaunchKernelGGL(enc_fwd, dim3(grid), dim3(NWAVES * 64), LDS_BYTES, stream, a); }
#else
    a.ph_lo = 0; a.ph_hi = NPH;
    hipLaunchKernelGGL(enc_fwd, dim3(grid), dim3(NWAVES * 64), LDS_BYTES, stream, a);
#endif
    const hipError_t le = hipPeekAtLastError();
    if (le != hipSuccess) fprintf(stderr, "kernel_launch: launch failed: %s\n", hipGetErrorName(le));
}
```

```cpp
#include <hip/hip_runtime.h>
#include <cstdio>
#include <cstdint>

#ifndef SKIP_NORM
#define SKIP_NORM 0
#endif
#ifndef SKIP_POOL
#define SKIP_POOL 0
#endif
#ifndef SKIP_GATE
#define SKIP_GATE 0
#endif
#ifndef SKIP_P0
#define SKIP_P0 0
#endif
#ifndef ECHO_MASK
#define ECHO_MASK 0ull
#endif
#ifndef ECHO_MUL
#define ECHO_MUL 1
#endif
#ifndef MK_PER_PHASE_LAUNCH
#define MK_PER_PHASE_LAUNCH 0
#endif

__device__ __forceinline__ void xcd_wait2(unsigned* bar_, unsigned target, int wid, unsigned setoff = 0u);
namespace pg8 {
#define PG8_LAS __attribute__((address_space(3)))
typedef unsigned short bf16_t;
typedef short bf16x8 __attribute__((ext_vector_type(8)));
typedef float f32x4 __attribute__((ext_vector_type(4)));
typedef float f32x2 __attribute__((ext_vector_type(2)));
typedef unsigned u32x4 __attribute__((ext_vector_type(4)));
constexpr int BM = 256, BK = 64, HALF = 128, HTB = HALF * BK * 2  , STAGE_BYTES = 8 * HTB, NXCD = 8;

__host__ __device__ __forceinline__ int lds_byte(int r, int c) { const int st = (r >> 4) * 2 + (c >> 5), rr = r & 15, cc = c & 31, ob = rr * 64 + cc * 2; return st * 1024 + (ob ^ (((ob >> 9) & 1) << 5)); }
__host__ __device__ __forceinline__ void stage_rc(int b, int& R, int& C) { const int st = b / 1024, sb = b % 1024, swz = sb ^ (((sb >> 9) & 1) << 5); R = (st >> 1) * 16 + swz / 64; C = (st & 1) * 32 + (swz % 64) / 2; }
__host__ __device__ __forceinline__ int perm32(int rho) { const int n = rho >> 4, i = rho & 15; return 8 * (i >> 2) + 4 * n + (i & 3); }

struct Unit { int pm, pn; };
struct Gemm { const bf16_t* A; const bf16_t* Bt; int lda, ldb, M, N, K, a_kshift, a_kcols; };

struct StaticOrder {
    int nM, nN, nwg, G, c, WGM, rev;
    __host__ __device__ void init(int M, int N, int G_, int c_, int wgm = 4, int rev_ = 0) { nM = M / BM; nN = N / BM; nwg = nM * nN; G = G_; c = c_; WGM = wgm; rev = (rev_ && nwg % G_ == 0) ? nwg / G_ : 0; }
    __host__ __device__ bool next(int i, Unit& u) const {
        const long L = (long)(rev ? rev - 1 - i : i) * G + c; if (i < 0 || L < 0 || L >= nwg) return false;
        int wgid = (int)L; { const int q = nwg / NXCD, r = nwg % NXCD, xcd = wgid % NXCD, off = wgid / NXCD; wgid = (xcd < r ? xcd * (q + 1) : r * (q + 1) + (xcd - r) * q) + off; }
        const int nig = WGM * nN, gid = wgid / nig, fm = gid * WGM, gsz = (nM - fm) < WGM ? (nM - fm) : WGM;
        u.pm = fm + ((wgid % nig) % gsz); u.pn = (wgid % nig) / gsz; return true;
    }
    __device__ __forceinline__ void a_ready(const Unit&) const {}
    __device__ __forceinline__ void done(const Unit&) const {}
};

__device__ __forceinline__ int lane_asm() { int l; asm volatile("v_mbcnt_lo_u32_b32 %0, -1, 0\n\tv_mbcnt_hi_u32_b32 %0, -1, %0" : "=v"(l)); return l; }
__device__ __forceinline__ float shfl_xor_l(float v, int mask, int lane) { return __builtin_bit_cast(float, __builtin_amdgcn_ds_bpermute((lane ^ mask) << 2, __builtin_bit_cast(int, v))); }
__device__ __forceinline__ float row_sum16(float v) {
    v += __builtin_bit_cast(float, __builtin_amdgcn_update_dpp(0, __builtin_bit_cast(int, v), 0x111, 0xf, 0xf, true));
    v += __builtin_bit_cast(float, __builtin_amdgcn_update_dpp(0, __builtin_bit_cast(int, v), 0x112, 0xf, 0xf, true));
    v += __builtin_bit_cast(float, __builtin_amdgcn_update_dpp(0, __builtin_bit_cast(int, v), 0x114, 0xf, 0xf, true));
    v += __builtin_bit_cast(float, __builtin_amdgcn_update_dpp(0, __builtin_bit_cast(int, v), 0x118, 0xf, 0xf, true));
    return v;
}
__device__ __forceinline__ unsigned cvt_pk_bf16(float lo, float hi) { unsigned r; asm volatile("v_cvt_pk_bf16_f32 %0, %1, %2" : "=v"(r) : "v"(lo), "v"(hi)); return r; }
__device__ __forceinline__ f32x2 gelu_pk(f32x2 v) {
    f32x2 a; a.x = __builtin_fminf(__builtin_fabsf(v.x), 6.0f); a.y = __builtin_fminf(__builtin_fabsf(v.y), 6.0f);
    f32x2 p = a * 5.38297500e-06f + 4.88906356e-05f; p = p * a + 3.80035750e-05f; p = p * a + 3.27762633e-03f; p = p * a + 2.11410062e-02f; p = p * a + 4.98673470e-02f; p = p * a + 1.0f;
    p = p * p; p = p * p; p = p * p; p = p * p;
    const float m = p.x * p.y, rr = __builtin_amdgcn_rcpf(m + m);
    f32x2 q; q.x = rr * p.y; q.y = rr * p.x;
    const f32x2 z = {0.f, 0.f};
    return __builtin_elementwise_max(v, z) - a * q;
}
__device__ __forceinline__ f32x4 gelu4(f32x4 v) { const f32x2 a = gelu_pk((f32x2){v[0], v[1]}), b = gelu_pk((f32x2){v[2], v[3]}); return (f32x4){a.x, a.y, b.x, b.y}; }

__device__ __forceinline__ int batch_of_tile(int p) { return p < 32 ? 0 : (p < 64 ? 1 : 2); }
constexpr float SSQ_SCALE = 1024.0f, SSQ_INV = 1.0f / 1024.0f;
__device__ __forceinline__ void norm_prefetch(const float* rowsrc, const float* colsrc, PG8_LAS unsigned char* tab, int wid) {
    const int lane = lane_asm(), part = wid & 3;
    const float* src = ((wid >> 2) ? colsrc : rowsrc) + part * 64 + lane;
    __builtin_amdgcn_global_load_lds((const unsigned*)src, (PG8_LAS unsigned*)(tab + (wid >> 2) * 1024 + part * 256), 4, 0, 0);
}
template <bool SWAPPED>
__device__ __forceinline__ void norm_prepass(f32x4 (&acc)[2][2][4][2], const PG8_LAS unsigned char* tab, float inv_nd, float eps, int wr, int wc, int fr, int fq) {
    const PG8_LAS float* rt = (const PG8_LAS float*)tab + wr * 64 + fr; const PG8_LAS float* ct = (const PG8_LAS float*)(tab + 1024) + wc * 32 + 8 * fq;
    f32x4 cvv[2][2];
#pragma unroll
    for (int bj = 0; bj < 2; ++bj)
#pragma unroll
        for (int n = 0; n < 2; ++n) { f32x4 q = *(const PG8_LAS f32x4*)(ct + bj * HALF + 4 * n);
            if (SWAPPED) { const u32x4 qi = __builtin_bit_cast(u32x4, q); q = (f32x4){(float)qi[0], (float)qi[1], (float)qi[2], (float)qi[3]} * (SSQ_INV * inv_nd) + eps; q = (f32x4){__builtin_amdgcn_rsqf(q[0]), __builtin_amdgcn_rsqf(q[1]), __builtin_amdgcn_rsqf(q[2]), __builtin_amdgcn_rsqf(q[3])}; }
            cvv[bj][n] = q; }
#pragma unroll
    for (int ai = 0; ai < 2; ++ai)
#pragma unroll
        for (int m = 0; m < 4; ++m) { float r = rt[ai * HALF + m * 16]; if (!SWAPPED) r = __builtin_amdgcn_rsqf((float)__builtin_bit_cast(unsigned, r) * (SSQ_INV * inv_nd) + eps);
#pragma unroll
            for (int bj = 0; bj < 2; ++bj) { if (SWAPPED) { acc[ai][bj][m][0] = acc[ai][bj][m][0] * cvv[bj][0] + r; acc[ai][bj][m][1] = acc[ai][bj][m][1] * cvv[bj][1] + r; }
                                             else         { acc[ai][bj][m][0] = acc[ai][bj][m][0] * r + cvv[bj][0]; acc[ai][bj][m][1] = acc[ai][bj][m][1] * r + cvv[bj][1]; } } }
}
template <int ACT, bool NORMED> struct EpiBf16 {
    static constexpr bool PERM = true;
    static constexpr bool PREF = NORMED, RESTAGE = false;
    bf16_t* O; int ldc; const float* cs; const float* nss; const float* ncv; int ncvstride; PG8_LAS unsigned char* tabs;
    __device__ __forceinline__ void prefetch(const Unit& u, int wid, int buf) const { norm_prefetch(nss + u.pm * BM, ncv + (size_t)batch_of_tile(u.pm) * ncvstride + u.pn * BM, tabs + buf * 2048, wid); }
    __device__ __forceinline__ void operator()(f32x4 (&acc)[2][2][4][2], const Unit& u, int wr, int wc, int fr, int fq, int buf) const {
        if constexpr (NORMED) norm_prepass<false>(acc, tabs + buf * 2048, 1.0f / 2048.0f, 1e-6f, wr, wc, fr, fq);
        const int row0 = u.pm * BM + wr * 64 + fr, col0 = u.pn * BM + wc * 32 + 8 * fq;
        f32x4 sv[2][2];
#pragma unroll
        for (int bj = 0; bj < 2; ++bj)
#pragma unroll
            for (int n = 0; n < 2; ++n) sv[bj][n] = (ACT == 3) ? *(const f32x4*)(cs + col0 + bj * HALF + 4 * n) : (f32x4){1.f, 1.f, 1.f, 1.f};
#pragma unroll
        for (int ai = 0; ai < 2; ++ai)
#pragma unroll
            for (int m = 0; m < 4; ++m) { bf16_t* rowp = O + (size_t)(row0 + ai * HALF + m * 16) * ldc + col0;
#pragma unroll
                for (int bj = 0; bj < 2; ++bj) { f32x4 v0 = acc[ai][bj][m][0], v1 = acc[ai][bj][m][1];
                    if (ACT == 1) { v0 = gelu4(v0); v1 = gelu4(v1); }
                    if (ACT == 2) { v0 = __builtin_elementwise_max(v0, (f32x4){0.f, 0.f, 0.f, 0.f}); v1 = __builtin_elementwise_max(v1, (f32x4){0.f, 0.f, 0.f, 0.f}); v0 = v0 * v0; v1 = v1 * v1; }
                    if (ACT == 3) { v0 = v0 * sv[bj][0]; v1 = v1 * sv[bj][1]; }
                    u32x4 w; w.x = cvt_pk_bf16(v0[0], v0[1]); w.y = cvt_pk_bf16(v0[2], v0[3]); w.z = cvt_pk_bf16(v1[0], v1[1]); w.w = cvt_pk_bf16(v1[2], v1[3]);
                    *(u32x4*)(rowp + bj * HALF) = w; } }
    }
};
struct EpiVT {
    static constexpr bool PERM = true;
    static constexpr bool PREF = true, RESTAGE = false;
    bf16_t* VT; int ldt; float* ssp; int ssld; const float* nss; const float* ncv; int ncvstride; PG8_LAS unsigned char* tabs;
    __device__ __forceinline__ void prefetch(const Unit& u, int wid, int buf) const { norm_prefetch(ncv + (size_t)batch_of_tile(u.pn) * ncvstride + u.pm * BM, nss + u.pn * BM, tabs + buf * 2048, wid); }
    __device__ __forceinline__ void operator()(f32x4 (&acc)[2][2][4][2], const Unit& u, int wr, int wc, int fr, int fq, int buf) const {
        const int row0 = u.pm * BM + wr * 64 + fr, col0 = u.pn * BM + wc * 32 + 8 * fq;
        norm_prepass<true>(acc, tabs + buf * 2048, 1.0f / 2048.0f, 1e-6f, wr, wc, fr, fq);
        f32x4 ss[2][2];
#pragma unroll
        for (int bj = 0; bj < 2; ++bj)
#pragma unroll
            for (int n = 0; n < 2; ++n) ss[bj][n] = (f32x4){0.f, 0.f, 0.f, 0.f};
#pragma unroll
        for (int ai = 0; ai < 2; ++ai)
#pragma unroll
            for (int m = 0; m < 4; ++m) { bf16_t* rowp = VT + (size_t)(row0 + ai * HALF + m * 16) * ldt + col0;
#pragma unroll
                for (int bj = 0; bj < 2; ++bj) { const f32x4 v0 = gelu4(acc[ai][bj][m][0]), v1 = gelu4(acc[ai][bj][m][1]);
                    ss[bj][0] += v0 * v0; ss[bj][1] += v1 * v1;
                    u32x4 w; w.x = cvt_pk_bf16(v0[0], v0[1]); w.y = cvt_pk_bf16(v0[2], v0[3]); w.z = cvt_pk_bf16(v1[0], v1[1]); w.w = cvt_pk_bf16(v1[2], v1[3]);
                    *(u32x4*)(rowp + bj * HALF) = w; } }
#pragma unroll
        for (int bj = 0; bj < 2; ++bj)
#pragma unroll
            for (int n = 0; n < 2; ++n)
#pragma unroll
                for (int j = 0; j < 4; ++j) ss[bj][n][j] = row_sum16(ss[bj][n][j]);
        if (fr == 15) { float* p = ssp + (size_t)(u.pm * 2 + wr) * ssld + col0;
#pragma unroll
            for (int bj = 0; bj < 2; ++bj) { *(f32x4*)(p + bj * HALF) = ss[bj][0]; *(f32x4*)(p + bj * HALF + 4) = ss[bj][1]; } }
    }
};
struct EpiGate {
    static constexpr bool PERM = true;
    static constexpr bool PREF = true;
    static constexpr bool RESTAGE = true;
    static constexpr int SB0 = 131072, SB1 = 32768, SB2 = 98304, GTAB = 57344;
    bf16_t* Gt; int ldc; const bf16_t* VT; int ldt; const bf16_t* WsS; const float* gain; const float* b_s; PG8_LAS unsigned char* lb; const float* nss; const float* ncv; int ncvstride; PG8_LAS unsigned char* tabs; unsigned* lbar; unsigned ltarget;
    __device__ __forceinline__ void prefetch(const Unit& u, int wid, int buf) const { norm_prefetch(nss + u.pm * BM, ncv + (size_t)batch_of_tile(u.pm) * ncvstride + u.pn * BM, tabs + buf * 2048, wid); }
    __device__ __forceinline__ void late_wait(int wid) const { if (lbar) ::xcd_wait2(lbar, ltarget, wid); }
    __device__ __forceinline__ void operator()(f32x4 (&acc)[2][2][4][2], const Unit& u, int wr, int wc, int fr_, int fq_, int buf) const {
        int fr = fr_, fq = fq_; asm volatile("" : "+v"(fr), "+v"(fq));
        const int wid = wr * 4 + wc, h = u.pn / 3;
#define PG8_GSB(k) (((k) % 3) == 0 ? SB0 : (((k) % 3) == 1 ? SB1 : SB2))
#define PG8_GADDR() const int lane = fq * 16 + fr; \
        const unsigned voff = ((unsigned)(u.pn * BM + wr * HALF + wc * 32 + 8 * (fr >> 2) + (fr & 3)) * (unsigned)ldt + 8u * fq + (unsigned)(2 * u.pm) * 128u) * 2u; \
        const unsigned woff = ((unsigned)(((2 * u.pm) * 8 + h) * 8 + wid) * 2048u + lane * 8u) * 2u; const unsigned vrow4 = (unsigned)ldt * 8u
#define PG8_GISSUE(k) do { const int ai_ = (k) >> 2, kb_ = (k) & 3; PG8_LAS unsigned char* d_ = lb + PG8_GSB(k); \
            __builtin_amdgcn_global_load_lds((const unsigned*)((const char*)WsS + (woff + (unsigned)(ai_ * (8 * 8 * 2048) + kb_ * 512) * 2u)), (PG8_LAS unsigned*)(d_ + wid * 1024), 16, 0, 0); \
            __builtin_amdgcn_global_load_lds((const unsigned*)((const char*)VT + (voff + (unsigned)(ai_ * 128 + kb_ * 32) * 2u)), (PG8_LAS unsigned*)(d_ + 8192 + (wid * 2) * 1024), 16, 0, 0); \
            __builtin_amdgcn_global_load_lds((const unsigned*)((const char*)VT + (voff + vrow4 + (unsigned)(ai_ * 128 + kb_ * 32) * 2u)), (PG8_LAS unsigned*)(d_ + 8192 + (wid * 2) * 1024 + 1024), 16, 0, 0); } while (0)
        {   PG8_GADDR();
            PG8_GISSUE(0);
            if (wid < 4) __builtin_amdgcn_global_load_lds((const unsigned*)(gain + u.pn * BM + wid * 64 + lane), (PG8_LAS unsigned*)(lb + GTAB + wid * 256), 4, 0, 0);
            else if (wid < 6) __builtin_amdgcn_global_load_lds((const unsigned*)(b_s + h * 128 + (wid - 4) * 64 + lane), (PG8_LAS unsigned*)(lb + GTAB + 1024 + (wid - 4) * 256), 4, 0, 0);
            PG8_GISSUE(1); PG8_GISSUE(2); }
        __builtin_amdgcn_sched_barrier(0);
        norm_prepass<false>(acc, tabs + buf * 2048, 1.0f / 2048.0f, 1e-6f, wr, wc, fr, fq);
        __builtin_amdgcn_sched_barrier(0);
        asm volatile("" : "+v"(fr), "+v"(fq));
        PG8_GADDR();
        const int rwo = (4 * wr) * 1024 + lane * 16, rvo = 8192 + (wc * 2) * 1024 + lane * 16;
        f32x4 mx[2][4][2];
#define PG8_GGELU(ai, kb, q) do { constexpr int bjg_ = (kb) >> 1, mg_ = 2 * ((kb) & 1) + ((q) >> 1), ng_ = (q) & 1; acc[ai][bjg_][mg_][ng_] = gelu4(acc[ai][bjg_][mg_][ng_]); asm volatile("" : "+v"(acc[ai][bjg_][mg_][ng_])); } while (0)
#define PG8_GMMA(m, W) do { _Pragma("unroll") for (int bj = 0; bj < 2; ++bj) { mx[bj][m][0] = __builtin_amdgcn_mfma_f32_16x16x32_bf16(vtf[bj][0], W, mx[bj][m][0], 0, 0, 0); \
                                                                            mx[bj][m][1] = __builtin_amdgcn_mfma_f32_16x16x32_bf16(vtf[bj][1], W, mx[bj][m][1], 0, 0, 0); } } while (0)
#define PG8_GSTEP(k, WAITN) do { constexpr int ai = (k) >> 2, kb = (k) & 3; \
            asm volatile("s_waitcnt lgkmcnt(0)" ::: "memory"); asm volatile("s_waitcnt vmcnt(" #WAITN ")" ::: "memory"); __builtin_amdgcn_s_barrier(); asm volatile("" ::: "memory"); \
            if ((k) >= 1 && (k) + 2 <= 7) PG8_GISSUE(((k) >= 1 && (k) + 2 <= 7) ? (k) + 2 : 7); __builtin_amdgcn_sched_barrier(0); \
            if (kb == 0) { _Pragma("unroll") for (int bj = 0; bj < 2; ++bj) _Pragma("unroll") for (int m = 0; m < 4; ++m) { mx[bj][m][0] = (f32x4){0.f, 0.f, 0.f, 0.f}; mx[bj][m][1] = (f32x4){0.f, 0.f, 0.f, 0.f}; } } \
            { const PG8_LAS unsigned char* rw = lb + PG8_GSB(k) + rwo; const PG8_LAS unsigned char* rv = lb + PG8_GSB(k) + rvo; \
              bf16x8 vtf[2][2], wsfA, wsfB; \
              _Pragma("unroll") for (int bj = 0; bj < 2; ++bj) { vtf[bj][0] = *(const PG8_LAS bf16x8*)(rv + bj * 8192); vtf[bj][1] = *(const PG8_LAS bf16x8*)(rv + bj * 8192 + 1024); } \
              wsfA = *(const PG8_LAS bf16x8*)(rw); __builtin_amdgcn_sched_barrier(0); \
              PG8_GGELU(ai, kb, 0); __builtin_amdgcn_sched_barrier(0); \
              wsfB = *(const PG8_LAS bf16x8*)(rw + 1024); PG8_GMMA(0, wsfA); PG8_GGELU(ai, kb, 1); __builtin_amdgcn_sched_barrier(0); \
              wsfA = *(const PG8_LAS bf16x8*)(rw + 2048); PG8_GMMA(1, wsfB); PG8_GGELU(ai, kb, 2); __builtin_amdgcn_sched_barrier(0); \
              wsfB = *(const PG8_LAS bf16x8*)(rw + 3072); PG8_GMMA(2, wsfA); PG8_GGELU(ai, kb, 3); __builtin_amdgcn_sched_barrier(0); \
              PG8_GMMA(3, wsfB); } \
            __builtin_amdgcn_sched_barrier(0); \
            if (kb == 3) {     \
                f32x4 gv[2][2]; \
                _Pragma("unroll") for (int bj = 0; bj < 2; ++bj) { gv[bj][0] = *(const PG8_LAS f32x4*)(lb + GTAB + (wc * 32 + 8 * fq + bj * HALF) * 4); gv[bj][1] = *(const PG8_LAS f32x4*)(lb + GTAB + (wc * 32 + 8 * fq + bj * HALF) * 4 + 16); } \
                _Pragma("unroll") for (int m = 0; m < 4; ++m) { const int p = wr * 64 + m * 16 + fr; const float bsv = *(const PG8_LAS float*)(lb + GTAB + 1024 + p * 4); \
                    bf16_t* rowp = Gt + (size_t)(u.pm * BM + ai * HALF + p) * ldc + u.pn * BM + wc * 32 + 8 * fq; \
                    _Pragma("unroll") for (int bj = 0; bj < 2; ++bj) { const f32x4 v0 = acc[ai][bj][m][0] * (mx[bj][m][0] * gv[bj][0] + bsv), v1 = acc[ai][bj][m][1] * (mx[bj][m][1] * gv[bj][1] + bsv); \
                        u32x4 w; w.x = cvt_pk_bf16(v0[0], v0[1]); w.y = cvt_pk_bf16(v0[2], v0[3]); w.z = cvt_pk_bf16(v1[0], v1[1]); w.w = cvt_pk_bf16(v1[2], v1[3]); \
                        *(u32x4*)(rowp + bj * HALF) = w; } } \
                __builtin_amdgcn_sched_barrier(0); } } while (0)
        PG8_GSTEP(0, 6); PG8_GSTEP(1, 3); PG8_GSTEP(2, 3); PG8_GSTEP(3, 3); PG8_GSTEP(4, 11); PG8_GSTEP(5, 11); PG8_GSTEP(6, 3); PG8_GSTEP(7, 0);
        asm volatile("s_waitcnt lgkmcnt(0)" ::: "memory"); __builtin_amdgcn_s_barrier(); asm volatile("" ::: "memory");
#undef PG8_GSTEP
#undef PG8_GMMA
#undef PG8_GGELU
#undef PG8_GISSUE
#undef PG8_GADDR
#undef PG8_GSB
    }
};

struct EpiResid {
    static constexpr bool PERM = true, PREF = false, RESTAGE = false;
    bf16_t* X; int ldc; const float* gate; int gstride; bf16_t* XS; const float* gsn; int gsstride; float* ssn; const float* xin0; const float* xin1;
    __device__ __forceinline__ void prefetch(const Unit&, int, int) const {}
    __device__ __forceinline__ void operator()(f32x4 (&acc)[2][2][4][2], const Unit& u, int wr, int wc, int fr, int fq, int) const {
        const int row0 = u.pm * BM + wr * 64 + fr, col0 = u.pn * BM + wc * 32 + 8 * fq;
        const int b = batch_of_tile(u.pm);
        const float* gp = gate + (size_t)b * gstride + col0;
        int ln = fq * 16 + fr; asm volatile("" : "+v"(ln));
        f32x4 gv[2][2], sv[2][2];
#pragma unroll
        for (int bj = 0; bj < 2; ++bj) { gv[bj][0] = *(const f32x4*)(gp + bj * HALF); gv[bj][1] = *(const f32x4*)(gp + bj * HALF + 4); }
        if (XS) { const float* sp_ = gsn + (size_t)b * gsstride + col0;
#pragma unroll
            for (int bj = 0; bj < 2; ++bj) { sv[bj][0] = *(const f32x4*)(sp_ + bj * HALF); sv[bj][1] = *(const f32x4*)(sp_ + bj * HALF + 4); } }
#pragma unroll
        for (int ai = 0; ai < 2; ++ai)
#pragma unroll
            for (int mp = 0; mp < 2; ++mp) {
                f32x4 xx[2][2][2];
#pragma unroll
                for (int mm = 0; mm < 2; ++mm) { const int rrow = row0 + ai * HALF + (2 * mp + mm) * 16;
                    if (xin0) { const float* rowp = (u.pm < 64 ? xin0 + (size_t)rrow * ldc : xin1 + (size_t)(rrow - 16384) * ldc) + col0;
#pragma unroll
                        for (int bj = 0; bj < 2; ++bj) { xx[mm][bj][0] = *(const f32x4*)(rowp + bj * HALF); xx[mm][bj][1] = *(const f32x4*)(rowp + bj * HALF + 4); } }
                    else { const bf16_t* rowp = X + (size_t)rrow * ldc + col0;
#pragma unroll
                        for (int bj = 0; bj < 2; ++bj) { const u32x4 w = *(const u32x4*)(rowp + bj * HALF);
                            xx[mm][bj][0] = (f32x4){__builtin_bit_cast(float, w.x << 16), __builtin_bit_cast(float, w.x & 0xffff0000u), __builtin_bit_cast(float, w.y << 16), __builtin_bit_cast(float, w.y & 0xffff0000u)};
                            xx[mm][bj][1] = (f32x4){__builtin_bit_cast(float, w.z << 16), __builtin_bit_cast(float, w.z & 0xffff0000u), __builtin_bit_cast(float, w.w << 16), __builtin_bit_cast(float, w.w & 0xffff0000u)}; } } }
#pragma unroll
                for (int mm = 0; mm < 2; ++mm) { const int m = 2 * mp + mm, row = row0 + ai * HALF + m * 16; float ssq = 0.f;
#pragma unroll
                    for (int bj = 0; bj < 2; ++bj) { const f32x4 x0 = xx[mm][bj][0] + gv[bj][0] * acc[ai][bj][m][0], x1 = xx[mm][bj][1] + gv[bj][1] * acc[ai][bj][m][1];
                        u32x4 xw; xw.x = cvt_pk_bf16(x0[0], x0[1]); xw.y = cvt_pk_bf16(x0[2], x0[3]); xw.z = cvt_pk_bf16(x1[0], x1[1]); xw.w = cvt_pk_bf16(x1[2], x1[3]);
                        *(u32x4*)(X + (size_t)row * ldc + col0 + bj * HALF) = xw;
                        if (XS) { ssq += ((x0[0] * x0[0] + x0[1] * x0[1]) + (x0[2] * x0[2] + x0[3] * x0[3])) + ((x1[0] * x1[0] + x1[1] * x1[1]) + (x1[2] * x1[2] + x1[3] * x1[3]));
                            const f32x4 y0 = x0 * sv[bj][0], y1 = x1 * sv[bj][1];
                            u32x4 w; w.x = cvt_pk_bf16(y0[0], y0[1]); w.y = cvt_pk_bf16(y0[2], y0[3]); w.z = cvt_pk_bf16(y1[0], y1[1]); w.w = cvt_pk_bf16(y1[2], y1[3]);
                            *(u32x4*)(XS + (size_t)row * ldc + col0 + bj * HALF) = w; } }
                    if (XS) { ssq += shfl_xor_l(ssq, 16, ln); ssq += shfl_xor_l(ssq, 32, ln); if (fq == 0) atomicAdd((unsigned*)ssn + row, (unsigned)(ssq * SSQ_SCALE + 0.5f)); } }
                asm volatile("" ::: "memory"); }
    }
};

template <class Epi, class Sched, bool ALIGN_EPI>
__device__ __forceinline__ void gemm_phase(PG8_LAS unsigned char* lds, const Gemm g, const Sched& S, const Epi& E, const int wave_s) {
    int wid_ = wave_s; asm volatile("" : "+s"(wid_));
    const int wid = wid_, wr = wid >> 2, wc = wid & 3;
    const int K = g.K, nt = K / BK;
    unsigned voffA[2], voffB[2]; int aoff, boff;
#define PG8_LANE_SETUP() do { const int lane_ = lane_asm(), tid_ = wid * 64 + lane_, fr_ = lane_ & 15, fq_ = lane_ >> 4; \
        _Pragma("unroll") for (int i = 0; i < 2; ++i) { int R, C; stage_rc(tid_ * 16 + i * 8192, R, C); const int Rb = Epi::PERM ? ((R & ~31) + perm32(R & 31)) : R; \
            voffA[i] = (unsigned)(R * g.lda + C) * 2u; voffB[i] = (unsigned)(Rb * g.ldb + C) * 2u; } \
        aoff = lds_byte(wr * 64 + fr_, fq_ * 8); boff = lds_byte(wc * 32 + fr_, fq_ * 8); } while (0)
    PG8_LANE_SETUP();
    const size_t kstep = (size_t)(BK * 2);
    const size_t hstepA = (size_t)HALF * g.lda * 2, hstepB = (size_t)HALF * g.ldb * 2;
    const size_t tstepA = 2 * hstepA, tstepB = 2 * hstepB;
    const unsigned ldsw = (unsigned)wid * 1024u;
#define PG8_ABASE(u) ((const char*)g.A + (size_t)(u).pm * tstepA + (size_t)(((u).pn >> g.a_kshift) * g.a_kcols) * 2)
#define PG8_BBASE(u) ((const char*)g.Bt + (size_t)(u).pn * tstepB)
#define PG8_SA(b, h) (((b) * 2 + (h)) * HTB)
#define PG8_SB(b, h) ((4 + (b) * 2 + (h)) * HTB)
#define PG8_STAGE(bufoff, gbase, voff) do { _Pragma("unroll") for (int _i = 0; _i < 2; ++_i) \
        __builtin_amdgcn_global_load_lds((const unsigned*)((const char*)(gbase) + (voff)[_i]), (PG8_LAS unsigned*)(lds + (bufoff) + ldsw + _i * 8192), 16, 0, 0); } while (0)
#define PG8_LDA(dst, b, h) do { _Pragma("unroll") for (int m = 0; m < 4; ++m) _Pragma("unroll") for (int k = 0; k < 2; ++k) dst[m][k] = *(const PG8_LAS bf16x8*)(lds + PG8_SA(b, h) + aoff + m * 2048 + k * 1024); } while (0)
#define PG8_LDB(dst, b, h) do { _Pragma("unroll") for (int n = 0; n < 2; ++n) _Pragma("unroll") for (int k = 0; k < 2; ++k) dst[n][k] = *(const PG8_LAS bf16x8*)(lds + PG8_SB(b, h) + boff + n * 2048 + k * 1024); } while (0)
#define PG8_MMA(ai, bj, At, Bt) do { __builtin_amdgcn_s_setprio(1); _Pragma("unroll") for (int m = 0; m < 4; ++m) _Pragma("unroll") for (int n = 0; n < 2; ++n) _Pragma("unroll") for (int k = 0; k < 2; ++k) \
        acc[ai][bj][m][n] = __builtin_amdgcn_mfma_f32_16x16x32_bf16(Bt[n][k], At[m][k], acc[ai][bj][m][n], 0, 0, 0); __builtin_amdgcn_s_setprio(0); } while (0)
#define PG8_MMA_HEAD(ai, At, B0_) do { __builtin_amdgcn_s_setprio(1); _Pragma("unroll") for (int k = 0; k < 2; ++k) \
        acc[ai][0][0][0] = __builtin_amdgcn_mfma_f32_16x16x32_bf16(B0_[0][k], At[0][k], acc[ai][0][0][0], 0, 0, 0); } while (0)
#define PG8_MMA_TAIL(ai, At, B0_, B1_) do { _Pragma("unroll") for (int k = 0; k < 2; ++k) acc[ai][0][0][1] = __builtin_amdgcn_mfma_f32_16x16x32_bf16(B0_[1][k], At[0][k], acc[ai][0][0][1], 0, 0, 0); \
        _Pragma("unroll") for (int m = 1; m < 4; ++m) _Pragma("unroll") for (int n = 0; n < 2; ++n) _Pragma("unroll") for (int k = 0; k < 2; ++k) \
        acc[ai][0][m][n] = __builtin_amdgcn_mfma_f32_16x16x32_bf16(B0_[n][k], At[m][k], acc[ai][0][m][n], 0, 0, 0); \
        _Pragma("unroll") for (int m = 0; m < 4; ++m) _Pragma("unroll") for (int n = 0; n < 2; ++n) _Pragma("unroll") for (int k = 0; k < 2; ++k) \
        acc[ai][1][m][n] = __builtin_amdgcn_mfma_f32_16x16x32_bf16(B1_[n][k], At[m][k], acc[ai][1][m][n], 0, 0, 0); __builtin_amdgcn_s_setprio(0); } while (0)
#define PG8_WAIT_V(n) asm volatile("s_waitcnt vmcnt(" #n ")" ::: "memory")
#define PG8_WAIT_L(n) asm volatile("s_waitcnt lgkmcnt(" #n ")" ::: "memory")
#define PG8_BAR __builtin_amdgcn_s_barrier()
#define PG8_SCHED __builtin_amdgcn_sched_barrier(0)
    Unit cur, nxt; int ui = 0;
    if (!S.next(0, cur)) return;
    f32x4 acc[2][2][4][2];
#pragma unroll
    for (int a = 0; a < 2; ++a)
#pragma unroll
        for (int b = 0; b < 2; ++b)
#pragma unroll
            for (int m = 0; m < 4; ++m)
#pragma unroll
                for (int n = 0; n < 2; ++n) acc[a][b][m][n] = (f32x4){0.f, 0.f, 0.f, 0.f};
    bf16x8 At[4][2], B0[2][2], B1[2][2];
    const char* cA = PG8_ABASE(cur); const char* cB = PG8_BBASE(cur);
    S.a_ready(cur);
    if constexpr (Epi::PREF) E.prefetch(cur, wid, 0);
    PG8_STAGE(PG8_SB(0, 0), cB, voffB); PG8_STAGE(PG8_SB(0, 1), cB + hstepB, voffB); PG8_STAGE(PG8_SA(0, 0), cA, voffA); PG8_STAGE(PG8_SA(0, 1), cA + hstepA, voffA);
    if (wr == 1) PG8_BAR;
    PG8_WAIT_V(2); PG8_BAR;
    PG8_STAGE(PG8_SB(1, 0), cB + kstep, voffB); PG8_STAGE(PG8_SA(1, 0), cA + kstep, voffA); PG8_STAGE(PG8_SB(1, 1), cB + hstepB + kstep, voffB);
    PG8_WAIT_V(6); PG8_BAR;
    for (;;) {
        const bool has_next = S.next(ui + 1, nxt);
        const char* nA = has_next ? PG8_ABASE(nxt) : cA; const char* nB = has_next ? PG8_BBASE(nxt) : cB;
        for (int t = 0; t < nt; t += 2) {
            const bool last = (t == nt - 2);
            const char* a1 = cA + (size_t)(t + 1) * kstep;
            const char* a2 = last ? nA : cA + (size_t)(t + 2) * kstep; const char* b2 = last ? nB : cB + (size_t)(t + 2) * kstep;
            const char* a3 = a2 + kstep; const char* b3 = b2 + kstep;
            if (last && has_next) S.a_ready(nxt);
            PG8_LDB(B0, 0, 0); PG8_LDB(B1, 0, 1); PG8_SCHED; PG8_LDA(At, 0, 0); PG8_STAGE(PG8_SA(1, 1), a1 + hstepA, voffA);
            PG8_WAIT_V(8); PG8_WAIT_L(0); PG8_MMA_HEAD(0, At, B0); PG8_SCHED; PG8_BAR; PG8_SCHED; PG8_MMA_TAIL(0, At, B0, B1); PG8_BAR; PG8_SCHED;
            PG8_LDA(At, 0, 1); PG8_STAGE(PG8_SB(0, 0), b2, voffB); PG8_STAGE(PG8_SB(0, 1), b2 + hstepB, voffB); PG8_STAGE(PG8_SA(0, 0), a2, voffA);
            PG8_WAIT_V(8); PG8_WAIT_L(0); PG8_MMA_HEAD(1, At, B0); PG8_SCHED; PG8_BAR; PG8_SCHED; PG8_MMA_TAIL(1, At, B0, B1); PG8_BAR; PG8_SCHED;
            PG8_LDB(B0, 1, 0); PG8_LDB(B1, 1, 1); PG8_SCHED; PG8_LDA(At, 1, 0); PG8_STAGE(PG8_SA(0, 1), a2 + hstepA, voffA);
            PG8_WAIT_V(8); PG8_WAIT_L(0); PG8_MMA_HEAD(0, At, B0); PG8_SCHED; PG8_BAR; PG8_SCHED; PG8_MMA_TAIL(0, At, B0, B1); PG8_BAR; PG8_SCHED;
            PG8_LDA(At, 1, 1); if (!(Epi::RESTAGE && last)) { PG8_STAGE(PG8_SB(1, 0), b3, voffB); PG8_STAGE(PG8_SB(1, 1), b3 + hstepB, voffB); PG8_STAGE(PG8_SA(1, 0), a3, voffA); }
            PG8_WAIT_V(8); PG8_WAIT_L(0); PG8_MMA_HEAD(1, At, B0); PG8_SCHED; PG8_BAR; PG8_SCHED; PG8_MMA_TAIL(1, At, B0, B1); PG8_BAR; PG8_SCHED;
        }
        if constexpr (ALIGN_EPI) { if (wr == 0) PG8_BAR; }
        if constexpr (Epi::PREF && Epi::RESTAGE) { if (has_next) E.prefetch(nxt, wid, (ui + 1) & 1); }
        if constexpr (Epi::RESTAGE) { if (ui == 0) E.late_wait(wid); }
        { const int lane_e = lane_asm(); E(acc, cur, wr, wc, lane_e & 15, lane_e >> 4, ui & 1); } S.done(cur);
        if constexpr (Epi::PREF && !Epi::RESTAGE) { if (has_next) E.prefetch(nxt, wid, (ui + 1) & 1); }
        if (!has_next) break;
#pragma unroll
        for (int a = 0; a < 2; ++a)
#pragma unroll
            for (int b = 0; b < 2; ++b)
#pragma unroll
                for (int m = 0; m < 4; ++m)
#pragma unroll
                    for (int n = 0; n < 2; ++n) acc[a][b][m][n] = (f32x4){0.f, 0.f, 0.f, 0.f};
        cur = nxt; cA = nA; cB = nB; ++ui;
        PG8_LANE_SETUP();
        if constexpr (Epi::RESTAGE) { PG8_STAGE(PG8_SB(1, 0), cB + kstep, voffB); PG8_STAGE(PG8_SB(1, 1), cB + hstepB + kstep, voffB); PG8_STAGE(PG8_SA(1, 0), cA + kstep, voffA); }
        if constexpr (ALIGN_EPI) { if (wr == 1) PG8_BAR; }
    }
    PG8_WAIT_V(0);
    if constexpr (!ALIGN_EPI) { if (wr == 0) PG8_BAR; }
    PG8_BAR;
#undef PG8_LANE_SETUP
#undef PG8_ABASE
#undef PG8_BBASE
#undef PG8_SA
#undef PG8_SB
#undef PG8_STAGE
#undef PG8_LDA
#undef PG8_LDB
#undef PG8_MMA
#undef PG8_MMA_HEAD
#undef PG8_MMA_TAIL
#undef PG8_WAIT_V
#undef PG8_WAIT_L
#undef PG8_BAR
#undef PG8_SCHED
}
}

constexpr int NWAVES = 8;
constexpr int D = 2048, T = 32768, DEPTH = 4, NBATCH = 3;
constexpr int FF = 8192, SFF = 12288, SHALF = 6144, NHEADS = 8, HDIM = 768, CHUNK = 128, NMOD = 6, PGRP = 512;
constexpr int VTLD = T + 64;
constexpr int NSSP = 48;
constexpr float EPS = 1e-6f;

constexpr size_t MiB = 1u << 20;
constexpr size_t WS_CTL = 0, CTL_ZERO_BYTES = 57344;
constexpr size_t WS_MODV = 1 * MiB;
constexpr size_t WS_SSP = 2 * MiB;
constexpr size_t WS_WPIN = 8 * MiB;
constexpr size_t WS_WPGRP = 24 * MiB;
constexpr size_t WS_WPOUT = 28 * MiB;
constexpr size_t WS_WSIN = 44 * MiB;
constexpr size_t WS_WSOUT = 140 * MiB;
constexpr size_t WS_W1 = 188 * MiB;
constexpr size_t WS_W2 = 316 * MiB;
constexpr size_t WS_H = 444 * MiB;
constexpr size_t WS_BIG = 572 * MiB;
constexpr size_t WS_WSS = 1341 * MiB;
constexpr size_t WS_SSX = 1405 * MiB;
constexpr size_t SSX_BYTES = (size_t)9 * 32768 * 4;
constexpr size_t WS_GS = 64 * 1024;
constexpr size_t WS_CVM = 1407 * MiB;
constexpr size_t WS_CV1 = 1 * MiB + 640 * 1024;
constexpr size_t WS_XB = 1408 * MiB;
constexpr size_t WS_END = 1536 * MiB;
constexpr int CW_BAR = 4096;

#define LAS __attribute__((address_space(3)))
typedef unsigned short bf16;
typedef unsigned v4u __attribute__((ext_vector_type(4)));
typedef unsigned v2u __attribute__((ext_vector_type(2)));
typedef float f32x4 __attribute__((ext_vector_type(4)));
typedef short bf16x8 __attribute__((ext_vector_type(8)));
#define LDS_WAIT() asm volatile("s_waitcnt lgkmcnt(0)" ::: "memory")
__device__ __forceinline__ unsigned f2bf(float f) { unsigned u = __builtin_bit_cast(unsigned, f); return (u + 0x7fffu + ((u >> 16) & 1u)) >> 16; }
__device__ __forceinline__ unsigned pk2(float lo, float hi) { return f2bf(lo) | (f2bf(hi) << 16); }
__device__ __forceinline__ float bflo(unsigned w) { return __builtin_bit_cast(float, w << 16); }
__device__ __forceinline__ float bfhi(unsigned w) { return __builtin_bit_cast(float, w & 0xffff0000u); }

#define XB_TMO      128
#define XB_XCNT(j)  (256  + 64 * (j))
#define XB_XSUB(j)  (1280 + 64 * (j))
#define XB_XGEN(j)  (2304 + 64 * (j))
#define XB_TOP      3328
#define XB_TOPGEN   3392
#define XCD_BAR_WORDS 3456
#define XB_XSUB2(j) (3456 + 64 * (j))
#define XB_TOP2     4480
#define XB_TOPGEN2  4544
#define XB_XGEN2(j) (4608 + 64 * (j))
#define XB_LSUB(j)  (7808 + 64 * (j))
#define XB_LGEN(j)  (8832 + 64 * (j))
#define XB_SET(s)   ((s) * 2176u)
#define XB_SPIN_CAP (1u << 18)

__device__ __forceinline__ unsigned xb_ld(unsigned* p)              { return __hip_atomic_load(p, __ATOMIC_RELAXED, __HIP_MEMORY_SCOPE_AGENT); }
__device__ __forceinline__ unsigned xb_add(unsigned* p, unsigned v) { return __hip_atomic_fetch_add(p, v, __ATOMIC_RELAXED, __HIP_MEMORY_SCOPE_AGENT); }
__device__ __forceinline__ unsigned xb_xcc_id() { return (unsigned)__builtin_amdgcn_s_getreg((3 << 11) | 20) & 0xFu; }
#define XB_SPIN(cond, bar) do { unsigned _sp = 0; while (cond) { __builtin_amdgcn_s_sleep(1); \
    if ((++_sp & 255u) == 0u) { if (xb_ld(&(bar)[XB_TMO])) break; if (_sp > XB_SPIN_CAP) { atomicAdd(&(bar)[XB_TMO], 1u); break; } } } } while (0)

struct XcdBarrier {
    unsigned* bar; unsigned x;
    volatile LAS unsigned* st;
};
__device__ __forceinline__ XcdBarrier xcd_barrier_post(unsigned* bar, volatile LAS unsigned* st) {
    XcdBarrier b; b.bar = bar; b.x = xb_xcc_id(); b.st = st;
    if (threadIdx.x == 0) { const unsigned rank = xb_add(&bar[XB_XCNT(b.x)], 1u); st[2] = rank; st[3] = b.x; }
    return b;
}
__device__ __forceinline__ void xcd_barrier_complete(unsigned* bar, unsigned x, unsigned& nloc, unsigned& nx) {
    const unsigned G = gridDim.x * gridDim.y * gridDim.z;
    unsigned sum, cnt, mine, sp = 0u;
    for (;;) {
        sum = 0u; cnt = 0u; mine = 0u;
#pragma unroll
        for (unsigned j = 0; j < 16; ++j) { const unsigned c = xb_ld(&bar[XB_XCNT(j)]); sum += c; cnt += (c > 0u) ? 1u : 0u; mine = (j == x) ? c : mine; }
        if (sum == G) break;
        __builtin_amdgcn_s_sleep(1);
        if ((++sp & 255u) == 0u) { if (xb_ld(&bar[XB_TMO])) break; if (sp > XB_SPIN_CAP) { atomicAdd(&bar[XB_TMO], 1u); break; } }
    }
    nloc = mine > 0u ? mine : 1u; nx = cnt > 0u ? cnt : 1u;
}
__device__ __forceinline__ void xcd_barrier(const XcdBarrier& b, const int wave_s) {
    asm volatile("s_waitcnt vmcnt(0)" ::: "memory");
    __syncthreads();
    if (wave_s == 0 && pg8::lane_asm() == 0) {
        unsigned* bar = b.bar; asm volatile("" : "+s"(bar));
        __builtin_amdgcn_s_waitcnt(0);
        const unsigned bx_ = xb_xcc_id();
        unsigned nloc = b.st[0], nx = b.st[1];
        if (nloc == 0u) { xcd_barrier_complete(bar, bx_, nloc, nx); b.st[0] = nloc; b.st[1] = nx; }
        const unsigned old = xb_add(&bar[XB_XSUB(bx_)], 1u);
        const unsigned gen = old / nloc;
        if (old + 1u == (gen + 1u) * nloc) {
            __builtin_amdgcn_fence(__ATOMIC_RELEASE, "agent");
            asm volatile("s_waitcnt vmcnt(0)" ::: "memory");
            const unsigned og = xb_add(&bar[XB_TOP], 1u);
            const unsigned tg = og / nx;
            if (og + 1u == (tg + 1u) * nx) xb_add(&bar[XB_TOPGEN], 1u);
            else XB_SPIN(xb_ld(&bar[XB_TOPGEN]) == tg, bar);
            __builtin_amdgcn_fence(__ATOMIC_ACQUIRE, "agent");
            xb_add(&bar[XB_XGEN(bx_)], 1u);
            asm volatile("s_waitcnt vmcnt(0)" ::: "memory");
        } else {
            XB_SPIN(xb_ld(&bar[XB_XGEN(bx_)]) == gen, bar);
            __builtin_amdgcn_fence(__ATOMIC_ACQUIRE, "agent");
            asm volatile("s_waitcnt vmcnt(0)" ::: "memory");
        }
    }
    __syncthreads();
}
__device__ __forceinline__ void xcd_local_barrier(const XcdBarrier& b, const int wave_s) {
    asm volatile("s_waitcnt vmcnt(0)" ::: "memory");
    __syncthreads();
    if (wave_s == 0 && pg8::lane_asm() == 0) {
        unsigned* bar = b.bar; asm volatile("" : "+s"(bar));
        __builtin_amdgcn_s_waitcnt(0);
        const unsigned bx_ = xb_xcc_id();
        const unsigned nloc = b.st[0];
        const unsigned old = xb_add(&bar[XB_LSUB(bx_)], 1u);
        const unsigned gen = old / nloc;
        if (old + 1u == (gen + 1u) * nloc) xb_add(&bar[XB_LGEN(bx_)], 1u);
        else XB_SPIN(xb_ld(&bar[XB_LGEN(bx_)]) == gen, bar);
        __builtin_amdgcn_fence(__ATOMIC_ACQUIRE, "agent");
        asm volatile("s_waitcnt vmcnt(0)" ::: "memory");
    }
    __syncthreads();
}
__device__ __forceinline__ void xcd_arrive2(const XcdBarrier& b, const int wave_s, const unsigned setoff = 0u) {
    asm volatile("s_waitcnt vmcnt(0)" ::: "memory");
    __syncthreads();
    if (wave_s == 0 && pg8::lane_asm() == 0) {
        unsigned* bar = b.bar; asm volatile("" : "+s"(bar));
        __builtin_amdgcn_s_waitcnt(0);
        const unsigned bx_ = xb_xcc_id();
        unsigned nloc = b.st[0], nx = b.st[1];
        if (nloc == 0u) { xcd_barrier_complete(bar, bx_, nloc, nx); b.st[0] = nloc; b.st[1] = nx; }
        const unsigned old = xb_add(&bar[setoff + XB_XSUB2(bx_)], 1u);
        const unsigned gen = old / nloc;
        if (old + 1u == (gen + 1u) * nloc) {
            __builtin_amdgcn_fence(__ATOMIC_RELEASE, "agent");
            asm volatile("s_waitcnt vmcnt(0)" ::: "memory");
            const unsigned og = xb_add(&bar[setoff + XB_TOP2], 1u);
            const unsigned tg = og / nx;
            if (og + 1u == (tg + 1u) * nx) {
                xb_add(&bar[setoff + XB_TOPGEN2], 1u);
#pragma unroll
                for (unsigned jx = 0; jx < 16; ++jx) xb_add(&bar[setoff + XB_XGEN2(jx)], 1u);
            }
            asm volatile("s_waitcnt vmcnt(0)" ::: "memory");
        }
    }
}
__device__ __forceinline__ void xcd_wait2(unsigned* bar_, unsigned target, int wid, unsigned setoff) {
    if (wid == 0 && pg8::lane_asm() == 0) {
        unsigned* bar = bar_; asm volatile("" : "+s"(bar));
        const unsigned bx_ = xb_xcc_id();
        XB_SPIN(xb_ld(&bar[setoff + XB_XGEN2(bx_)]) < target, bar);
        __builtin_amdgcn_fence(__ATOMIC_ACQUIRE, "agent");
        asm volatile("s_waitcnt vmcnt(0)" ::: "memory");
    }
    asm volatile("" ::: "memory"); __builtin_amdgcn_s_barrier(); asm volatile("" ::: "memory");
}

constexpr int RING_OFF = 0, RING_BYTES = 131072;
constexpr int SPARE_OFF = RING_BYTES, SPARE_BYTES = 24576;
constexpr int TAB_OFF = SPARE_OFF + SPARE_BYTES + 128;
constexpr int MISC_OFF = SPARE_OFF + SPARE_BYTES;
constexpr int LDS_BYTES = 163840;

__device__ __forceinline__ int opaque_s(int v) { asm volatile("" : "+s"(v)); return v; }
__device__ __forceinline__ int otid(int wave_s) { return wave_s * 64 + pg8::lane_asm(); }
__device__ __forceinline__ float wave_sum(float v, int lane) {
#pragma unroll
    for (int o = 1; o < 64; o <<= 1) v += pg8::shfl_xor_l(v, o, lane);
    return v;
}

__device__ __forceinline__ void p0_transpose_item(const float* W, int K, int N, bf16* WT, LAS float* scr, int item, int lane) {
    const int nblk = N / 32, kb = item / nblk, nb = item % nblk, k0 = 64 * kb, n0 = 32 * nb;
#pragma unroll 8
    for (int i = 0; i < 32; ++i) { const int kk = 2 * i + (lane >> 5); scr[kk * 33 + (lane & 31)] = __builtin_nontemporal_load(W + (size_t)(k0 + kk) * N + n0 + (lane & 31)); }
    LDS_WAIT(); asm volatile("" ::: "memory");
    const int c = lane & 7;
#pragma unroll
    for (int j = 0; j < 4; ++j) { const int n = (lane >> 3) + 8 * j; const LAS float* s = scr + (8 * c) * 33 + n;
        v4u o; o.x = pk2(s[0 * 33], s[1 * 33]); o.y = pk2(s[2 * 33], s[3 * 33]); o.z = pk2(s[4 * 33], s[5 * 33]); o.w = pk2(s[6 * 33], s[7 * 33]);
        *(v4u*)(WT + (size_t)(n0 + n) * K + k0 + 8 * c) = o; }
    LDS_WAIT(); asm volatile("" ::: "memory");
}
__device__ __forceinline__ void p0_scale_item(const float* Wg, const float* scale, bf16* WG, int item, int lane) {
    const int mat = item >> 7;
#pragma unroll
    for (int q = 0; q < 8; ++q) { const size_t idx = (size_t)item * 2048 + q * 256 + lane * 4; const int e = (int)(idx & 511);
        const f32x4 w = *(const f32x4*)(Wg + idx) * *(const f32x4*)(scale + mat * 512 + e);
        v2u o; o.x = pk2(w[0], w[1]); o.y = pk2(w[2], w[3]); *(v2u*)(WG + idx) = o; }
}
__device__ __forceinline__ bool p0_stack(int& it, const float* W, int L, int K, int N, bf16* WT, LAS float* scr, int lane) {
    const int per = (K / 64) * (N / 32), tot = L * per;
    if (it >= tot) { it -= tot; return false; }
    const int l = it / per, r = it % per;
    p0_transpose_item(W + (size_t)l * K * N, K, N, WT + (size_t)l * K * N, scr, r, lane);
    return true;
}

__device__ __forceinline__ void gemv3_item(const float* W, size_t ldw, int e0, const LAS float* vec, const float* bias, float* out, size_t ostride, LAS float* red, int tid, int lane, int wave) {
    const int r4 = lane >> 4, c4 = (lane & 15) * 4;
    const float* wp = W + (size_t)(wave * 256 + r4) * ldw + e0 + c4;
    f32x4 a0 = {0.f, 0.f, 0.f, 0.f}, a1 = a0, a2 = a0;
#pragma unroll 16
    for (int it = 0; it < 64; ++it) { const f32x4 w = __builtin_nontemporal_load((const f32x4*)(wp + (size_t)it * 4 * ldw)); const int d = wave * 256 + it * 4 + r4;
        a0 += w * vec[d]; a1 += w * vec[2048 + d]; a2 += w * vec[4096 + d]; }
#pragma unroll
    for (int j = 0; j < 4; ++j) { a0[j] += __shfl_xor(a0[j], 16); a0[j] += __shfl_xor(a0[j], 32); a1[j] += __shfl_xor(a1[j], 16); a1[j] += __shfl_xor(a1[j], 32); a2[j] += __shfl_xor(a2[j], 16); a2[j] += __shfl_xor(a2[j], 32); }
    if (lane < 16) { *(LAS f32x4*)(red + (wave * 3 + 0) * 64 + c4) = a0; *(LAS f32x4*)(red + (wave * 3 + 1) * 64 + c4) = a1; *(LAS f32x4*)(red + (wave * 3 + 2) * 64 + c4) = a2; }
    __syncthreads();
    if (tid < 192) { const int b = tid / 64, c = tid % 64; float sacc = bias ? bias[e0 + c] : 0.f;
#pragma unroll
        for (int w = 0; w < 8; ++w) sacc += red[(w * 3 + b) * 64 + c];
        out[(size_t)b * ostride + e0 + c] = sacc; }
    __syncthreads();
}

struct Args {
    const float* in[20]; float* out; unsigned char* ws; int ph_lo, ph_hi;
};

__global__ void __launch_bounds__(NWAVES * 64, 2) enc_fwd(Args args) {
    extern __shared__ __attribute__((aligned(16))) unsigned char lds_raw[];
    LAS unsigned char* lds = (LAS unsigned char*)lds_raw;
    volatile LAS unsigned* MISC = (volatile LAS unsigned*)(lds + MISC_OFF);
    const int tid = threadIdx.x, lane = tid & 63, wave = __builtin_amdgcn_readfirstlane(tid >> 6), wave_s = wave;
    const int G = gridDim.x, bx = blockIdx.x;
    unsigned char* ws = args.ws;
    unsigned* ctl = (unsigned*)(ws + WS_CTL);
    bf16* X = (bf16*)(ws + WS_XB);
    float* MODV = (float*)(ws + WS_MODV);
    float* SSP = (float*)(ws + WS_SSP);
    bf16* Hb = (bf16*)(ws + WS_H);
    bf16* BIG = (bf16*)(ws + WS_BIG);

    for (int u = tid; u < 32; u += NWAVES * 64) ((LAS unsigned*)(lds + MISC_OFF))[u] = 0u;
    __syncthreads();
#if MK_PER_PHASE_LAUNCH
#define GRID_BAR() do { } while (0)
#else
    XcdBarrier bar = xcd_barrier_post(ctl + CW_BAR, MISC + 8);
#define GRID_BAR() xcd_barrier(bar, wave_s)
#endif
#if MK_PER_PHASE_LAUNCH
    const int lo = args.ph_lo;
#define IN(k) (lo == (k))
#else
#define IN(k) true
#endif
    unsigned long long echo_last = ECHO_MASK ? __builtin_amdgcn_s_memrealtime() : 0ull, echo_acc = 0ull;
#define ECHO_TICK(k) do { if (ECHO_MASK) { const unsigned long long now_ = __builtin_amdgcn_s_memrealtime(); if ((ECHO_MASK >> (k)) & 1ull) echo_acc += now_ - echo_last; echo_last = now_; } } while (0)
#define SEAM(k) do { if (IN(k) && IN((k) + 1)) GRID_BAR(); ECHO_TICK(k); } while (0)

    float* SSX = (float*)(ws + WS_SSX); float* GS = (float*)(ws + WS_GS); float* CVM = (float*)(ws + WS_CVM); float* CV1 = (float*)(ws + WS_CV1);
    if (IN(0) && !SKIP_P0) {
        { const f32x4 z4 = {0.f, 0.f, 0.f, 0.f}; for (int u = bx * (NWAVES * 64) + tid; u < 8 * T / 4; u += G * (NWAVES * 64)) *(f32x4*)(SSX + T + (size_t)u * 4) = z4; }
        LAS float* cact = (LAS float*)(lds + RING_OFF);
        LAS float* red = (LAS float*)(lds + RING_OFF + 32768);
        for (int u = tid; u < NBATCH * D; u += NWAVES * 64) { const int b = u / D, d = u % D; const float c = (b < 2) ? args.in[2][b * D + d] : args.in[3][d]; cact[u] = c / (1.0f + __expf(-c)); }
        __syncthreads();
        for (int item = bx; item < DEPTH * (NMOD * D / 64); item += G) {
            const int i = item / (NMOD * D / 64), e0 = (item % (NMOD * D / 64)) * 64;
            gemv3_item(args.in[6] + (size_t)i * D * (NMOD * D), NMOD * D, e0, cact, args.in[7] + (size_t)i * (NMOD * D), MODV + (size_t)i * NBATCH * (NMOD * D), NMOD * D, red, tid, lane, wave);
        }
#if !MK_PER_PHASE_LAUNCH
        xcd_arrive2(bar, wave_s, XB_SET(1));
#endif
        LAS float* scr = (LAS float*)(lds + RING_OFF + wave * 16384);
        const int gw = bx * NWAVES + wave, NGW = G * NWAVES;
        constexpr int NITEMS = 2 * (D / 64) * (D / 32) * 2 + 8 * (PGRP / 64) * (PGRP / 32) + 2 * (D / 64) * (SFF / 32) + 2 * (SHALF / 64) * (D / 32) + 4 * (D / 64) * (FF / 32) + 4 * (FF / 64) * (D / 32);
        for (int it0 = gw; it0 < NITEMS; it0 += NGW) {
            int it = it0;
            if (p0_stack(it, args.in[8], 2, D, D, (bf16*)(ws + WS_WPIN), scr, lane)) continue;
            if (it < 8 * (PGRP / 64) * (PGRP / 32)) { p0_scale_item(args.in[9], args.in[10], (bf16*)(ws + WS_WPGRP), it, lane); continue; }
            it -= 8 * (PGRP / 64) * (PGRP / 32);
            if (p0_stack(it, args.in[11], 2, D, D, (bf16*)(ws + WS_WPOUT), scr, lane)) continue;
            if (p0_stack(it, args.in[17], 4, D, FF, (bf16*)(ws + WS_W1), scr, lane)) continue;
            if (p0_stack(it, args.in[18], 4, FF, D, (bf16*)(ws + WS_W2), scr, lane)) continue;
            if (p0_stack(it, args.in[12], 2, D, SFF, (bf16*)(ws + WS_WSIN), scr, lane)) continue;
            p0_stack(it, args.in[16], 2, SHALF, D, (bf16*)(ws + WS_WSOUT), scr, lane);
        }
        __syncthreads();
    }
#if MK_PER_PHASE_LAUNCH
    SEAM(0);
#else
    xcd_arrive2(bar, wave_s, 0u); __syncthreads(); ECHO_TICK(0);
#endif
    int vcu = bx, xl = 0;
#if !MK_PER_PHASE_LAUNCH
    {   bool ok = (G % 8) == 0; unsigned* bw = ctl + CW_BAR;
#pragma unroll
        for (int jx = 0; jx < 16; ++jx) { const unsigned cjx = xb_ld(&bw[XB_XCNT(jx)]); ok = ok && (cjx == (jx < 8 ? (unsigned)(G / 8) : 0u)); }
        const unsigned rk = MISC[10], xc = MISC[11];
        if (ok && xc < 8u && rk < (unsigned)(G / 8)) { vcu = (int)(rk * 8u + xc); xl = 1; }
        vcu = __builtin_amdgcn_readfirstlane(vcu); xl = __builtin_amdgcn_readfirstlane(xl);
    }
#endif
    if (IN(1) && !SKIP_P0) {
#if !MK_PER_PHASE_LAUNCH
        xcd_wait2(ctl + CW_BAR, 1u, wave_s, XB_SET(1));
#endif
        {
            const int gt = bx * (NWAVES * 64) + tid;
            if (gt < 8 * NBATCH * D) { const int r = gt / (NBATCH * D), b = (gt / D) % NBATCH, c = gt % D, li = r >> 1, sub = r & 1;
                GS[gt] = args.in[sub ? 5 : 4][(size_t)li * D + c] * (1.0f + MODV[((size_t)li * NBATCH + b) * (NMOD * D) + (sub ? 4 : 1) * D + c]); }
        }
        {
            LAS float* gs = (LAS float*)(lds + RING_OFF);
            for (int rb = bx; rb < T / 128; rb += G) {
                const int r0 = rb * 128, b = r0 < 8192 ? 0 : (r0 < 16384 ? 1 : 2);
                { const int c = tid * 4; const f32x4 gq = *(const f32x4*)(args.in[4] + c), sc = *(const f32x4*)(MODV + (size_t)b * (NMOD * D) + D + c); *(LAS f32x4*)(gs + c) = gq * (sc + 1.0f); }
                __syncthreads();
                for (int rr = 0; rr < 16; rr += 2) { const int row = r0 + wave * 16 + rr;
                    const float* src = row < 16384 ? args.in[0] + (size_t)row * D : args.in[1] + (size_t)(row - 16384) * D;
                    f32x4 v[2][8];
#pragma unroll
                    for (int h = 0; h < 2; ++h)
#pragma unroll
                        for (int q = 0; q < 4; ++q) { v[h][2 * q] = *(const f32x4*)(src + (size_t)h * D + q * 512 + lane * 8); v[h][2 * q + 1] = *(const f32x4*)(src + (size_t)h * D + q * 512 + lane * 8 + 4); }
#pragma unroll
                    for (int h = 0; h < 2; ++h) { float ss = 0.f;
#pragma unroll
                        for (int q = 0; q < 4; ++q) { const f32x4 x0 = v[h][2 * q], x1 = v[h][2 * q + 1];
                            ss += ((x0[0] * x0[0] + x0[1] * x0[1]) + (x0[2] * x0[2] + x0[3] * x0[3])) + ((x1[0] * x1[0] + x1[1] * x1[1]) + (x1[2] * x1[2] + x1[3] * x1[3]));
                            const f32x4 o0 = x0 * *(const LAS f32x4*)(gs + q * 512 + lane * 8), o1 = x1 * *(const LAS f32x4*)(gs + q * 512 + lane * 8 + 4);
                            v4u w; w.x = pk2(o0[0], o0[1]); w.y = pk2(o0[2], o0[3]); w.z = pk2(o1[0], o1[1]); w.w = pk2(o1[2], o1[3]); *(v4u*)(Hb + (size_t)(row + h) * D + q * 512 + lane * 8) = w; }
                        ss = wave_sum(ss, lane); if (lane == 0) ((unsigned*)SSX)[row + h] = (unsigned)(ss * pg8::SSQ_SCALE + 0.5f); } }
                __syncthreads(); }
        }
#if !MK_PER_PHASE_LAUNCH
        xcd_wait2(ctl + CW_BAR, 1u, wave_s, 0u);
#endif
        {
            LAS float* vec = (LAS float*)(lds + RING_OFF);
            const int gw = bx * NWAVES + wave, NGW = G * NWAVES;
            for (int hf = 0; hf < 2; ++hf) {
                __syncthreads();
                for (int u = tid; u < 4 * NBATCH * (D / 4); u += NWAVES * 64) { const int sx = u / (NBATCH * (D / 4)), r = u % (NBATCH * (D / 4)), b = r / (D / 4), d4 = r % (D / 4), id = hf * 4 + sx, li = id >> 1, which = id & 1;
                    *(LAS f32x4*)(vec + (size_t)u * 4) = *(const f32x4*)(MODV + ((size_t)li * NBATCH + b) * (NMOD * D) + (which ? 3 : 0) * D + d4 * 4); }
                __syncthreads();
                for (int sx = 0; sx < 4; ++sx) { const int id = hf * 4 + sx, li = id >> 1, which = id & 1;
                    const LAS float* vs = vec + sx * (NBATCH * D);
                    const int N = which ? FF : ((li & 1) ? SFF : D);
                    const bf16* Wt = which ? (const bf16*)(ws + WS_W1) + (size_t)li * FF * D : ((li & 1) ? (const bf16*)(ws + WS_WSIN) + (size_t)(li >> 1) * SFF * D : (const bf16*)(ws + WS_WPIN) + (size_t)(li >> 1) * D * D);
                    float* out = which ? CV1 + (size_t)li * NBATCH * FF : CVM + (size_t)li * NBATCH * SFF; const size_t ostride = which ? FF : SFF;
                    for (int n = gw; n < N; n += 2 * NGW) {
                        const int n2 = n + NGW; const bool two = n2 < N; const int n2c = two ? n2 : n;
                        v4u wA[4], wB[4];
#pragma unroll
                        for (int q = 0; q < 4; ++q) wA[q] = *(const v4u*)(Wt + (size_t)n * D + q * 512 + lane * 8);
#pragma unroll
                        for (int q = 0; q < 4; ++q) wB[q] = *(const v4u*)(Wt + (size_t)n2c * D + q * 512 + lane * 8);
                        float a0 = 0.f, a1 = 0.f, a2 = 0.f, b0 = 0.f, b1 = 0.f, b2 = 0.f;
#pragma unroll
                        for (int q = 0; q < 4; ++q) { const LAS float* vp = vs + q * 512 + lane * 8;
                            const float wf[8] = {bflo(wA[q].x), bfhi(wA[q].x), bflo(wA[q].y), bfhi(wA[q].y), bflo(wA[q].z), bfhi(wA[q].z), bflo(wA[q].w), bfhi(wA[q].w)};
                            const float wg[8] = {bflo(wB[q].x), bfhi(wB[q].x), bflo(wB[q].y), bfhi(wB[q].y), bflo(wB[q].z), bfhi(wB[q].z), bflo(wB[q].w), bfhi(wB[q].w)};
#pragma unroll
                            for (int e = 0; e < 8; ++e) { const float v0 = vp[e], v1 = vp[D + e], v2 = vp[2 * D + e]; a0 += wf[e] * v0; a1 += wf[e] * v1; a2 += wf[e] * v2; b0 += wg[e] * v0; b1 += wg[e] * v1; b2 += wg[e] * v2; } }
                        a0 = wave_sum(a0, lane); a1 = wave_sum(a1, lane); a2 = wave_sum(a2, lane); b0 = wave_sum(b0, lane); b1 = wave_sum(b1, lane); b2 = wave_sum(b2, lane);
                        if (lane == 0) { out[n] = a0; out[ostride + n] = a1; out[2 * ostride + n] = a2; if (two) { out[n2] = b0; out[ostride + n2] = b1; out[2 * ostride + n2] = b2; } }
                    }
                }
            }
            __syncthreads();
        }
        __syncthreads();
    }
    SEAM(1);

    for (int i = 0; i < DEPTH; ++i) {
        const int j = i >> 1, pb = 2 + i * 6;
        const float* modl = MODV + (size_t)i * NBATCH * (NMOD * D);
        const float* ss1 = SSX + (size_t)(2 * i) * T; float* ss2 = SSX + (size_t)(2 * i + 1) * T; float* ss3 = SSX + (size_t)(2 * i + 2) * T;
        const float* cvm = CVM + (size_t)i * NBATCH * SFF; const float* cv1 = CV1 + (size_t)i * NBATCH * FF;
        if ((i & 1) == 0) {
            bf16* Z = BIG + (size_t)640 * MiB / 2; bf16* ZD = BIG + (size_t)512 * MiB / 2; bf16* WO2 = (bf16*)(ws + WS_WSS);
            if (IN(pb + 0)) {
                pg8::Gemm g{Hb, (const bf16*)(ws + WS_WPIN) + (size_t)j * D * D, D, D, T, D, D, 0, 0}; pg8::StaticOrder S; S.init(T, D, G, opaque_s(vcu));
                pg8::EpiBf16<0, true> E{Z, D, nullptr, ss1, cvm, SFF, lds + TAB_OFF};
                pg8::gemm_phase<pg8::EpiBf16<0, true>, pg8::StaticOrder, true>(lds + RING_OFF, g, S, E, wave_s);
            }
#if MK_PER_PHASE_LAUNCH
            SEAM(pb + 0);
#else
            xcd_arrive2(bar, wave_s);
#endif
            if (IN(pb + 1) && !SKIP_POOL) {
                {
                    pg8::Gemm g{(const bf16*)(ws + WS_WPOUT) + (size_t)j * D * D, (const bf16*)(ws + WS_WPGRP) + (size_t)j * D * PGRP, D, PGRP, D, D, PGRP, 1, PGRP}; pg8::StaticOrder S; S.init(D, D, G, opaque_s(vcu));
                    pg8::EpiBf16<0, false> E{WO2, D, nullptr, nullptr, nullptr, 0, lds + TAB_OFF};
                    pg8::gemm_phase<pg8::EpiBf16<0, false>, pg8::StaticOrder, true>(lds + RING_OFF, g, S, E, wave_s);
                }
#if !MK_PER_PHASE_LAUNCH
                xcd_wait2(ctl + CW_BAR, (unsigned)(i + 2), wave_s); ECHO_TICK(pb + 0);
#endif
                const int tid = otid(wave_s);
                int bxo = bx; asm volatile("" : "+s"(bxo));
                for (int seg = bxo; seg < T / 128; seg += G) {
                    const int half = tid >> 8, chunk = tid & 255, gsel = chunk >> 6, hw = 1 << gsel;
                    const int r0 = seg * 128 + half * 64;
                    const int s0 = r0 < 8192 ? 0 : (r0 < 16384 ? 8192 : 16384), s1 = r0 < 8192 ? 8192 : (r0 < 16384 ? 16384 : 32768);
                    const bf16* zc = Z + chunk * 8; bf16* oc = ZD + chunk * 8;
                    float sum[8];
#pragma unroll
                    for (int q = 0; q < 8; ++q) sum[q] = 0.f;
                    for (int t = r0 - hw; t <= r0 + hw - 1; ++t) if (t >= s0 && t < s1) { const v4u w = *(const v4u*)(zc + (size_t)t * D);
                        sum[0] += bflo(w.x); sum[1] += bfhi(w.x); sum[2] += bflo(w.y); sum[3] += bfhi(w.y); sum[4] += bflo(w.z); sum[5] += bfhi(w.z); sum[6] += bflo(w.w); sum[7] += bfhi(w.w); }
#pragma unroll 8
                    for (int t = r0; t < r0 + 64; ++t) {
                        const int lo_t = (t - hw > s0) ? t - hw : s0, hi_t = (t + hw - 1 < s1 - 1) ? t + hw - 1 : s1 - 1;
                        const float inv = 1.0f / (float)(hi_t - lo_t + 1);
                        const v4u zc4 = *(const v4u*)(zc + (size_t)t * D);
                        v4u add = {0u, 0u, 0u, 0u}, sub = {0u, 0u, 0u, 0u};
                        if (t + hw < s1) add = *(const v4u*)(zc + (size_t)(t + hw) * D);
                        if (t - hw >= s0) sub = *(const v4u*)(zc + (size_t)(t - hw) * D);
                        v4u o;
                        o.x = pk2(sum[0] * inv - bflo(zc4.x), sum[1] * inv - bfhi(zc4.x)); o.y = pk2(sum[2] * inv - bflo(zc4.y), sum[3] * inv - bfhi(zc4.y));
                        o.z = pk2(sum[4] * inv - bflo(zc4.z), sum[5] * inv - bfhi(zc4.z)); o.w = pk2(sum[6] * inv - bflo(zc4.w), sum[7] * inv - bfhi(zc4.w));
                        *(v4u*)(oc + (size_t)t * D) = o;
                        sum[0] += bflo(add.x) - bflo(sub.x); sum[1] += bfhi(add.x) - bfhi(sub.x); sum[2] += bflo(add.y) - bflo(sub.y); sum[3] += bfhi(add.y) - bfhi(sub.y);
                        sum[4] += bflo(add.z) - bflo(sub.z); sum[5] += bfhi(add.z) - bfhi(sub.z); sum[6] += bflo(add.w) - bflo(sub.w); sum[7] += bfhi(add.w) - bfhi(sub.w);
                    }
                }
            }
            SEAM(pb + 1);
            if (IN(pb + 3)) {
                pg8::Gemm g{ZD, WO2, D, D, T, D, D, 0, 0}; pg8::StaticOrder S; S.init(T, D, G, opaque_s(vcu));
                pg8::EpiResid E{X, D, modl + 2 * D, NMOD * D, Hb, GS + (size_t)(2 * i + 1) * NBATCH * D, D, ss2, i == 0 ? args.in[0] : (const float*)nullptr, args.in[1]};
                pg8::gemm_phase<pg8::EpiResid, pg8::StaticOrder, true>(lds + RING_OFF, g, S, E, wave_s);
            }
#if MK_PER_PHASE_LAUNCH
            SEAM(pb + 3);
#else
            if (xl) xcd_local_barrier(bar, wave_s); else GRID_BAR(); ECHO_TICK(pb + 3);
#endif
        } else {
            bf16* Gt = BIG; bf16* VT = BIG + (size_t)T * SHALF; bf16* WsS = (bf16*)(ws + WS_WSS);
            const bf16* wsin = (const bf16*)(ws + WS_WSIN) + (size_t)j * SFF * D;
            if (IN(pb + 0)) {
                pg8::Gemm g{wsin + (size_t)SHALF * D, Hb, D, D, SHALF, T, D, 0, 0}; pg8::StaticOrder S; S.init(SHALF, T, G, opaque_s(vcu), 16);
                pg8::EpiVT E{VT, VTLD, SSP, T, ss1, cvm + SHALF, SFF, lds + TAB_OFF};
                pg8::gemm_phase<pg8::EpiVT, pg8::StaticOrder, true>(lds + RING_OFF, g, S, E, wave_s);
            }
            SEAM(pb + 0);
            if (IN(pb + 1) && !SKIP_GATE) {
                LAS float* rinv = (LAS float*)(lds + RING_OFF);
                const float* w_s = args.in[14] + (size_t)j * NHEADS * CHUNK * CHUNK;
                const int tid = otid(wave_s);
                int bxo = bx; asm volatile("" : "+s"(bxo));
                for (int n = bxo; n < T / CHUNK; n += G) {
                    if (tid < CHUNK) { float sacc = 0.f;
#pragma unroll
                        for (int k = 0; k < NSSP; ++k) sacc += SSP[(size_t)k * T + n * CHUNK + tid];
                        rinv[tid] = 1.0f / sqrtf(sacc * (1.0f / SHALF) + EPS); }
                    __syncthreads();
#pragma unroll 8
                    for (int it = 0; it < 32; ++it) { const int h = it >> 2, unit = (it & 3) * 512 + tid, p = unit >> 4, q8 = unit & 15;
                        const float* wp = w_s + (size_t)h * CHUNK * CHUNK + p * CHUNK + q8 * 8;
                        const f32x4 w0 = *(const f32x4*)wp * *(const LAS f32x4*)(rinv + q8 * 8), w1 = *(const f32x4*)(wp + 4) * *(const LAS f32x4*)(rinv + q8 * 8 + 4);
                        v4u o; o.x = pk2(w0[0], w0[1]); o.y = pk2(w0[2], w0[3]); o.z = pk2(w1[0], w1[1]); o.w = pk2(w1[2], w1[3]);
                        *(v4u*)(WsS + ((((size_t)(n * 8 + h) * 8 + (p >> 4)) * 4 + (q8 >> 2)) * 64 + (q8 & 3) * 16 + (p & 15)) * 8) = o; }
                    __syncthreads();
                }
            }
#if MK_PER_PHASE_LAUNCH
            SEAM(pb + 1);
#else
            xcd_arrive2(bar, wave_s); ECHO_TICK(pb + 1);
#endif
            if (IN(pb + 2)) {
                pg8::Gemm g{Hb, wsin, D, D, T, SHALF, D, 0, 0}; pg8::StaticOrder S; S.init(T, SHALF, G, opaque_s(vcu));
                pg8::EpiGate E{Gt, SHALF, VT, VTLD, WsS, args.in[13] + (size_t)j * SHALF, args.in[15] + (size_t)j * NHEADS * CHUNK, lds, ss1, cvm, SFF, lds + TAB_OFF, MK_PER_PHASE_LAUNCH ? (unsigned*)nullptr : ctl + CW_BAR, (unsigned)(i + 2)};
                pg8::gemm_phase<pg8::EpiGate, pg8::StaticOrder, true>(lds + RING_OFF, g, S, E, wave_s);
            }
#if MK_PER_PHASE_LAUNCH
            SEAM(pb + 2);
#else
            if (xl) xcd_local_barrier(bar, wave_s); else GRID_BAR(); ECHO_TICK(pb + 2);
#endif
            if (IN(pb + 3)) {
                pg8::Gemm g{Gt, (const bf16*)(ws + WS_WSOUT) + (size_t)j * D * SHALF, SHALF, SHALF, T, D, SHALF, 0, 0}; pg8::StaticOrder S; S.init(T, D, G, opaque_s(vcu), 4, 1);
                pg8::EpiResid E{X, D, modl + 2 * D, NMOD * D, Hb, GS + (size_t)(2 * i + 1) * NBATCH * D, D, ss2, nullptr, nullptr};
                pg8::gemm_phase<pg8::EpiResid, pg8::StaticOrder, true>(lds + RING_OFF, g, S, E, wave_s);
            }
            SEAM(pb + 3);
        }

        bf16* A2 = BIG;
        if (IN(pb + 4)) {
            pg8::Gemm g{Hb, (const bf16*)(ws + WS_W1) + (size_t)i * FF * D, D, D, T, FF, D, 0, 0}; pg8::StaticOrder S; S.init(T, FF, G, opaque_s(vcu));
            pg8::EpiBf16<2, true> E{A2, FF, nullptr, ss2, cv1, FF, lds + TAB_OFF};
            pg8::gemm_phase<pg8::EpiBf16<2, true>, pg8::StaticOrder, true>(lds + RING_OFF, g, S, E, wave_s);
        }
#if MK_PER_PHASE_LAUNCH
        SEAM(pb + 4);
#else
        if (xl) xcd_local_barrier(bar, wave_s); else GRID_BAR(); ECHO_TICK(pb + 4);
#endif
        if (IN(pb + 5)) {
            pg8::Gemm g{A2, (const bf16*)(ws + WS_W2) + (size_t)i * D * FF, FF, FF, T, D, FF, 0, 0}; pg8::StaticOrder S; S.init(T, D, G, opaque_s(vcu), 4, 1);
            pg8::EpiResid E{X, D, modl + 5 * D, NMOD * D, (i + 1 < DEPTH) ? Hb : (bf16*)nullptr, GS + (size_t)(2 * i + 2 < 8 ? 2 * i + 2 : 0) * NBATCH * D, D, ss3, nullptr, nullptr};
            pg8::gemm_phase<pg8::EpiResid, pg8::StaticOrder, true>(lds + RING_OFF, g, S, E, wave_s);
        }
#if MK_PER_PHASE_LAUNCH
        SEAM(pb + 5);
#else
        if (xl && (i == 1 || i == DEPTH - 1)) xcd_local_barrier(bar, wave_s); else GRID_BAR(); ECHO_TICK(pb + 5);
#endif
    }

    if (IN(2 + DEPTH * 6)) {
        const float* fg = args.in[19];
        const int tid = otid(wave_s), lane = tid & 63, wave = __builtin_amdgcn_readfirstlane(tid >> 6);
        const int xq = vcu & 7, rq = vcu >> 3;
        const int rs = xl ? xq * (T / 8) + rq * NWAVES + wave : bx * NWAVES + wave, rstride = xl ? (G / 8) * NWAVES : G * NWAVES, rend = xl ? (xq + 1) * (T / 8) : T;
        for (int row = rs; row < rend; row += 2 * rstride) {
            const bool two = row + rstride < rend; const int row2 = two ? row + rstride : row;
            v4u w[4], w2[4];
#pragma unroll
            for (int q = 0; q < 4; ++q) w[q] = *(const v4u*)(X + (size_t)row * D + q * 512 + lane * 8);
#pragma unroll
            for (int q = 0; q < 4; ++q) w2[q] = *(const v4u*)(X + (size_t)row2 * D + q * 512 + lane * 8);
#pragma unroll
            for (int h = 0; h < 2; ++h) { if (h == 1 && !two) continue; float* orow = args.out + (size_t)(h ? row2 : row) * D; float ss = 0.f;
                f32x4 v[8];
#pragma unroll
                for (int q = 0; q < 4; ++q) { const v4u ww = h ? w2[q] : w[q]; v[2 * q] = (f32x4){bflo(ww.x), bfhi(ww.x), bflo(ww.y), bfhi(ww.y)}; v[2 * q + 1] = (f32x4){bflo(ww.z), bfhi(ww.z), bflo(ww.w), bfhi(ww.w)}; }
#pragma unroll
                for (int q = 0; q < 8; ++q) ss += (v[q][0] * v[q][0] + v[q][1] * v[q][1]) + (v[q][2] * v[q][2] + v[q][3] * v[q][3]);
                const float rinv = 1.0f / sqrtf(wave_sum(ss, lane) * (1.0f / D) + EPS);
#pragma unroll
                for (int q = 0; q < 8; ++q) { const int c = (q >> 1) * 512 + lane * 8 + (q & 1) * 4; const f32x4 g4 = *(const f32x4*)(fg + c); *(f32x4*)(orow + c) = v[q] * rinv * g4; } }
        }
    }
    if (ECHO_MASK) { ECHO_TICK(2 + DEPTH * 6);
        if (bx == 0 && otid(wave_s) < 64) { const unsigned long long t_end = __builtin_amdgcn_s_memrealtime() + (unsigned long long)ECHO_MUL * echo_acc; while (__builtin_amdgcn_s_memrealtime() < t_end) __builtin_amdgcn_s_sleep(8); } }
#undef IN
#undef SEAM
}

extern "C" void kernel_launch(void* const* d_in, const int* in_sizes, int n_in, void* d_out, int out_size, void* d_ws, size_t ws_size, hipStream_t stream) {
    static int grid = 0;
    if (grid == 0) {
        if (n_in != 20 || out_size != T * D || ws_size < WS_END) { fprintf(stderr, "kernel_launch: built for 20 inputs, out of %d floats, >= %zu bytes of workspace; got n_in %d, out %d, ws %zu; nothing launched\n", T * D, (size_t)WS_END, n_in, out_size, ws_size); grid = -1; return; }
        int dev = 0, cus = 0, per_cu = 0;
        if (hipGetDevice(&dev) != hipSuccess || hipDeviceGetAttribute(&cus, hipDeviceAttributeMultiprocessorCount, dev) != hipSuccess) { fprintf(stderr, "kernel_launch: hipGetDevice / hipDeviceGetAttribute failed\n"); grid = -1; return; }
        if (hipFuncSetAttribute((const void*)enc_fwd, hipFuncAttributeMaxDynamicSharedMemorySize, LDS_BYTES) != hipSuccess) { fprintf(stderr, "kernel_launch: hipFuncSetAttribute failed\n"); grid = -1; return; }
        if (hipOccupancyMaxActiveBlocksPerMultiprocessor(&per_cu, (const void*)enc_fwd, NWAVES * 64, LDS_BYTES) != hipSuccess || per_cu < 1) { fprintf(stderr, "kernel_launch: occupancy query reports %d workgroups per CU\n", per_cu); }
        (void)hipGetLastError();
        grid = cus;
    }
    if (grid < 0) return;
    if (hipMemsetAsync((char*)d_ws + WS_CTL, 0, CTL_ZERO_BYTES, stream) != hipSuccess) { fprintf(stderr, "kernel_launch: hipMemsetAsync failed\n"); return; }
    Args a{};
    for (int i = 0; i < 20; ++i) a.in[i] = (const float*)d_in[i];
    a.out = (float*)d_out; a.ws = (unsigned char*)d_ws;
    constexpr int NPH = 3 + DEPTH * 6;
#if MK_PER_PHASE_LAUNCH
    for (int p = 0; p < NPH; ++p) { a.ph_lo = p; a.ph_hi = p + 1; hipLaunchKernelGGL(enc_fwd, dim3(grid), dim3(NWAVES * 64), LDS_BYTES, stream, a); }
#else
    a.ph_lo = 0; a.ph_hi = NPH;
    hipLaunchKernelGGL(enc_fwd, dim3(grid), dim3(NWAVES * 64), LDS_BYTES, stream, a);
#endif
    const hipError_t le = hipPeekAtLastError();
    if (le != hipSuccess) fprintf(stderr, "kernel_launch: launch failed: %s\n", hipGetErrorName(le));
}
```

```cpp
#include <hip/hip_runtime.h>
#include <cstdio>
#include <cstdint>

#ifndef SKIP_NORM
#define SKIP_NORM 0
#endif
#ifndef SKIP_POOL
#define SKIP_POOL 0
#endif
#ifndef SKIP_GATE
#define SKIP_GATE 0
#endif
#ifndef SKIP_P0
#define SKIP_P0 0
#endif
#ifndef ECHO_MASK
#define ECHO_MASK 0ull
#endif
#ifndef ECHO_MUL
#define ECHO_MUL 1
#endif
#ifndef MK_PER_PHASE_LAUNCH
#define MK_PER_PHASE_LAUNCH 0
#endif

__device__ __forceinline__ void xcd_wait2(unsigned* bar_, unsigned target, int wid, unsigned setoff = 0u);
namespace pg8 {
#define PG8_LAS __attribute__((address_space(3)))
typedef unsigned short bf16_t;
typedef short bf16x8 __attribute__((ext_vector_type(8)));
typedef float f32x4 __attribute__((ext_vector_type(4)));
typedef float f32x2 __attribute__((ext_vector_type(2)));
typedef unsigned u32x4 __attribute__((ext_vector_type(4)));
constexpr int BM = 256, BK = 64, HALF = 128, HTB = HALF * BK * 2  , STAGE_BYTES = 8 * HTB, NXCD = 8;

__host__ __device__ __forceinline__ int lds_byte(int r, int c) { const int st = (r >> 4) * 2 + (c >> 5), rr = r & 15, cc = c & 31, ob = rr * 64 + cc * 2; return st * 1024 + (ob ^ (((ob >> 9) & 1) << 5)); }
__host__ __device__ __forceinline__ void stage_rc(int b, int& R, int& C) { const int st = b / 1024, sb = b % 1024, swz = sb ^ (((sb >> 9) & 1) << 5); R = (st >> 1) * 16 + swz / 64; C = (st & 1) * 32 + (swz % 64) / 2; }
__host__ __device__ __forceinline__ int perm32(int rho) { const int n = rho >> 4, i = rho & 15; return 8 * (i >> 2) + 4 * n + (i & 3); }

struct Unit { int pm, pn; };
struct Gemm { const bf16_t* A; const bf16_t* Bt; int lda, ldb, M, N, K, a_kshift, a_kcols; };

struct StaticOrder {
    int nM, nN, nwg, G, c, WGM, rev;
    __host__ __device__ void init(int M, int N, int G_, int c_, int wgm = 4, int rev_ = 0) { nM = M / BM; nN = N / BM; nwg = nM * nN; G = G_; c = c_; WGM = wgm; rev = (rev_ && nwg % G_ == 0) ? nwg / G_ : 0; }
    __host__ __device__ bool next(int i, Unit& u) const {
        const long L = (long)(rev ? rev - 1 - i : i) * G + c; if (i < 0 || L < 0 || L >= nwg) return false;
        int wgid = (int)L; { const int q = nwg / NXCD, r = nwg % NXCD, xcd = wgid % NXCD, off = wgid / NXCD; wgid = (xcd < r ? xcd * (q + 1) : r * (q + 1) + (xcd - r) * q) + off; }
        const int nig = WGM * nN, gid = wgid / nig, fm = gid * WGM, gsz = (nM - fm) < WGM ? (nM - fm) : WGM;
        u.pm = fm + ((wgid % nig) % gsz); u.pn = (wgid % nig) / gsz; return true;
    }
    __device__ __forceinline__ void a_ready(const Unit&) const {}
    __device__ __forceinline__ void done(const Unit&) const {}
};

__device__ __forceinline__ int lane_asm() { int l; asm volatile("v_mbcnt_lo_u32_b32 %0, -1, 0\n\tv_mbcnt_hi_u32_b32 %0, -1, %0" : "=v"(l)); return l; }
__device__ __forceinline__ float shfl_xor_l(float v, int mask, int lane) { return __builtin_bit_cast(float, __builtin_amdgcn_ds_bpermute((lane ^ mask) << 2, __builtin_bit_cast(int, v))); }
__device__ __forceinline__ float row_sum16(float v) {
    v += __builtin_bit_cast(float, __builtin_amdgcn_update_dpp(0, __builtin_bit_cast(int, v), 0x111, 0xf, 0xf, true));
    v += __builtin_bit_cast(float, __builtin_amdgcn_update_dpp(0, __builtin_bit_cast(int, v), 0x112, 0xf, 0xf, true));
    v += __builtin_bit_cast(float, __builtin_amdgcn_update_dpp(0, __builtin_bit_cast(int, v), 0x114, 0xf, 0xf, true));
    v += __builtin_bit_cast(float, __builtin_amdgcn_update_dpp(0, __builtin_bit_cast(int, v), 0x118, 0xf, 0xf, true));
    return v;
}
__device__ __forceinline__ unsigned cvt_pk_bf16(float lo, float hi) { unsigned r; asm volatile("v_cvt_pk_bf16_f32 %0, %1, %2" : "=v"(r) : "v"(lo), "v"(hi)); return r; }
__device__ __forceinline__ f32x2 gelu_pk(f32x2 v) {
    f32x2 a; a.x = __builtin_fminf(__builtin_fabsf(v.x), 6.0f); a.y = __builtin_fminf(__builtin_fabsf(v.y), 6.0f);
    f32x2 p = a * 5.38297500e-06f + 4.88906356e-05f; p = p * a + 3.80035750e-05f; p = p * a + 3.27762633e-03f; p = p * a + 2.11410062e-02f; p = p * a + 4.98673470e-02f; p = p * a + 1.0f;
    p = p * p; p = p * p; p = p * p; p = p * p;
    const float m = p.x * p.y, rr = __builtin_amdgcn_rcpf(m + m);
    f32x2 q; q.x = rr * p.y; q.y = rr * p.x;
    const f32x2 z = {0.f, 0.f};
    return __builtin_elementwise_max(v, z) - a * q;
}
__device__ __forceinline__ f32x4 gelu4(f32x4 v) { const f32x2 a = gelu_pk((f32x2){v[0], v[1]}), b = gelu_pk((f32x2){v[2], v[3]}); return (f32x4){a.x, a.y, b.x, b.y}; }

__device__ __forceinline__ int batch_of_tile(int p) { return p < 32 ? 0 : (p < 64 ? 1 : 2); }
constexpr float SSQ_SCALE = 1024.0f, SSQ_INV = 1.0f / 1024.0f;
__device__ __forceinline__ void norm_prefetch(const float* rowsrc, const float* colsrc, PG8_LAS unsigned char* tab, int wid) {
    const int lane = lane_asm(), part = wid & 3;
    const float* src = ((wid >> 2) ? colsrc : rowsrc) + part * 64 + lane;
    __builtin_amdgcn_global_load_lds((const unsigned*)src, (PG8_LAS unsigned*)(tab + (wid >> 2) * 1024 + part * 256), 4, 0, 0);
}
template <bool SWAPPED>
__device__ __forceinline__ void norm_prepass(f32x4 (&acc)[2][2][4][2], const PG8_LAS unsigned char* tab, float inv_nd, float eps, int wr, int wc, int fr, int fq) {
    const PG8_LAS float* rt = (const PG8_LAS float*)tab + wr * 64 + fr; const PG8_LAS float* ct = (const PG8_LAS float*)(tab + 1024) + wc * 32 + 8 * fq;
    f32x4 cvv[2][2];
#pragma unroll
    for (int bj = 0; bj < 2; ++bj)
#pragma unroll
        for (int n = 0; n < 2; ++n) { f32x4 q = *(const PG8_LAS f32x4*)(ct + bj * HALF + 4 * n);
            if (SWAPPED) { const u32x4 qi = __builtin_bit_cast(u32x4, q); q = (f32x4){(float)qi[0], (float)qi[1], (float)qi[2], (float)qi[3]} * (SSQ_INV * inv_nd) + eps; q = (f32x4){__builtin_amdgcn_rsqf(q[0]), __builtin_amdgcn_rsqf(q[1]), __builtin_amdgcn_rsqf(q[2]), __builtin_amdgcn_rsqf(q[3])}; }
            cvv[bj][n] = q; }
#pragma unroll
    for (int ai = 0; ai < 2; ++ai)
#pragma unroll
        for (int m = 0; m < 4; ++m) { float r = rt[ai * HALF + m * 16]; if (!SWAPPED) r = __builtin_amdgcn_rsqf((float)__builtin_bit_cast(unsigned, r) * (SSQ_INV * inv_nd) + eps);
#pragma unroll
            for (int bj = 0; bj < 2; ++bj) { if (SWAPPED) { acc[ai][bj][m][0] = acc[ai][bj][m][0] * cvv[bj][0] + r; acc[ai][bj][m][1] = acc[ai][bj][m][1] * cvv[bj][1] + r; }
                                             else         { acc[ai][bj][m][0] = acc[ai][bj][m][0] * r + cvv[bj][0]; acc[ai][bj][m][1] = acc[ai][bj][m][1] * r + cvv[bj][1]; } } }
}
template <int ACT, bool NORMED> struct EpiBf16 {
    static constexpr bool PERM = true;
    static constexpr bool PREF = NORMED, RESTAGE = false;
    bf16_t* O; int ldc; const float* cs; const float* nss; const float* ncv; int ncvstride; PG8_LAS unsigned char* tabs;
    __device__ __forceinline__ void prefetch(const Unit& u, int wid, int buf) const { norm_prefetch(nss + u.pm * BM, ncv + (size_t)batch_of_tile(u.pm) * ncvstride + u.pn * BM, tabs + buf * 2048, wid); }
    __device__ __forceinline__ void operator()(f32x4 (&acc)[2][2][4][2], const Unit& u, int wr, int wc, int fr, int fq, int buf) const {
        if constexpr (NORMED) norm_prepass<false>(acc, tabs + buf * 2048, 1.0f / 2048.0f, 1e-6f, wr, wc, fr, fq);
        const int row0 = u.pm * BM + wr * 64 + fr, col0 = u.pn * BM + wc * 32 + 8 * fq;
        f32x4 sv[2][2];
#pragma unroll
        for (int bj = 0; bj < 2; ++bj)
#pragma unroll
            for (int n = 0; n < 2; ++n) sv[bj][n] = (ACT == 3) ? *(const f32x4*)(cs + col0 + bj * HALF + 4 * n) : (f32x4){1.f, 1.f, 1.f, 1.f};
#pragma unroll
        for (int ai = 0; ai < 2; ++ai)
#pragma unroll
            for (int m = 0; m < 4; ++m) { bf16_t* rowp = O + (size_t)(row0 + ai * HALF + m * 16) * ldc + col0;
#pragma unroll
                for (int bj = 0; bj < 2; ++bj) { f32x4 v0 = acc[ai][bj][m][0], v1 = acc[ai][bj][m][1];
                    if (ACT == 1) { v0 = gelu4(v0); v1 = gelu4(v1); }
                    if (ACT == 2) { v0 = __builtin_elementwise_max(v0, (f32x4){0.f, 0.f, 0.f, 0.f}); v1 = __builtin_elementwise_max(v1, (f32x4){0.f, 0.f, 0.f, 0.f}); v0 = v0 * v0; v1 = v1 * v1; }
                    if (ACT == 3) { v0 = v0 * sv[bj][0]; v1 = v1 * sv[bj][1]; }
                    u32x4 w; w.x = cvt_pk_bf16(v0[0], v0[1]); w.y = cvt_pk_bf16(v0[2], v0[3]); w.z = cvt_pk_bf16(v1[0], v1[1]); w.w = cvt_pk_bf16(v1[2], v1[3]);
                    *(u32x4*)(rowp + bj * HALF) = w; } }
    }
};
struct EpiVT {
    static constexpr bool PERM = true;
    static constexpr bool PREF = true, RESTAGE = false;
    bf16_t* VT; int ldt; float* ssp; int ssld; const float* nss; const float* ncv; int ncvstride; PG8_LAS unsigned char* tabs;
    __device__ __forceinline__ void prefetch(const Unit& u, int wid, int buf) const { norm_prefetch(ncv + (size_t)batch_of_tile(u.pn) * ncvstride + u.pm * BM, nss + u.pn * BM, tabs + buf * 2048, wid); }
    __device__ __forceinline__ void operator()(f32x4 (&acc)[2][2][4][2], const Unit& u, int wr, int wc, int fr, int fq, int buf) const {
        const int row0 = u.pm * BM + wr * 64 + fr, col0 = u.pn * BM + wc * 32 + 8 * fq;
        norm_prepass<true>(acc, tabs + buf * 2048, 1.0f / 2048.0f, 1e-6f, wr, wc, fr, fq);
        f32x4 ss[2][2];
#pragma unroll
        for (int bj = 0; bj < 2; ++bj)
#pragma unroll
            for (int n = 0; n < 2; ++n) ss[bj][n] = (f32x4){0.f, 0.f, 0.f, 0.f};
#pragma unroll
        for (int ai = 0; ai < 2; ++ai)
#pragma unroll
            for (int m = 0; m < 4; ++m) { bf16_t* rowp = VT + (size_t)(row0 + ai * HALF + m * 16) * ldt + col0;
#pragma unroll
                for (int bj = 0; bj < 2; ++bj) { const f32x4 v0 = gelu4(acc[ai][bj][m][0]), v1 = gelu4(acc[ai][bj][m][1]);
                    ss[bj][0] += v0 * v0; ss[bj][1] += v1 * v1;
                    u32x4 w; w.x = cvt_pk_bf16(v0[0], v0[1]); w.y = cvt_pk_bf16(v0[2], v0[3]); w.z = cvt_pk_bf16(v1[0], v1[1]); w.w = cvt_pk_bf16(v1[2], v1[3]);
                    *(u32x4*)(rowp + bj * HALF) = w; } }
#pragma unroll
        for (int bj = 0; bj < 2; ++bj)
#pragma unroll
            for (int n = 0; n < 2; ++n)
#pragma unroll
                for (int j = 0; j < 4; ++j) ss[bj][n][j] = row_sum16(ss[bj][n][j]);
        if (fr == 15) { float* p = ssp + (size_t)(u.pm * 2 + wr) * ssld + col0;
#pragma unroll
            for (int bj = 0; bj < 2; ++bj) { *(f32x4*)(p + bj * HALF) = ss[bj][0]; *(f32x4*)(p + bj * HALF + 4) = ss[bj][1]; } }
    }
};
struct EpiGate {
    static constexpr bool PERM = true;
    static constexpr bool PREF = true;
    static constexpr bool RESTAGE = true;
    static constexpr int SB0 = 131072, SB1 = 32768, SB2 = 98304, GTAB = 57344;
    bf16_t* Gt; int ldc; const bf16_t* VT; int ldt; const bf16_t* WsS; const float* gain; const float* b_s; PG8_LAS unsigned char* lb; const float* nss; const float* ncv; int ncvstride; PG8_LAS unsigned char* tabs; unsigned* lbar; unsigned ltarget;
    __device__ __forceinline__ void prefetch(const Unit& u, int wid, int buf) const { norm_prefetch(nss + u.pm * BM, ncv + (size_t)batch_of_tile(u.pm) * ncvstride + u.pn * BM, tabs + buf * 2048, wid); }
    __device__ __forceinline__ void late_wait(int wid) const { if (lbar) ::xcd_wait2(lbar, ltarget, wid); }
    __device__ __forceinline__ void operator()(f32x4 (&acc)[2][2][4][2], const Unit& u, int wr, int wc, int fr_, int fq_, int buf) const {
        int fr = fr_, fq = fq_; asm volatile("" : "+v"(fr), "+v"(fq));
        const int wid = wr * 4 + wc, h = u.pn / 3;
#define PG8_GSB(k) (((k) % 3) == 0 ? SB0 : (((k) % 3) == 1 ? SB1 : SB2))
#define PG8_GADDR() const int lane = fq * 16 + fr; \
        const unsigned voff = ((unsigned)(u.pn * BM + wr * HALF + wc * 32 + 8 * (fr >> 2) + (fr & 3)) * (unsigned)ldt + 8u * fq + (unsigned)(2 * u.pm) * 128u) * 2u; \
        const unsigned woff = ((unsigned)(((2 * u.pm) * 8 + h) * 8 + wid) * 2048u + lane * 8u) * 2u; const unsigned vrow4 = (unsigned)ldt * 8u
#define PG8_GISSUE(k) do { const int ai_ = (k) >> 2, kb_ = (k) & 3; PG8_LAS unsigned char* d_ = lb + PG8_GSB(k); \
            __builtin_amdgcn_global_load_lds((const unsigned*)((const char*)WsS + (woff + (unsigned)(ai_ * (8 * 8 * 2048) + kb_ * 512) * 2u)), (PG8_LAS unsigned*)(d_ + wid * 1024), 16, 0, 0); \
            __builtin_amdgcn_global_load_lds((const unsigned*)((const char*)VT + (voff + (unsigned)(ai_ * 128 + kb_ * 32) * 2u)), (PG8_LAS unsigned*)(d_ + 8192 + (wid * 2) * 1024), 16, 0, 0); \
            __builtin_amdgcn_global_load_lds((const unsigned*)((const char*)VT + (voff + vrow4 + (unsigned)(ai_ * 128 + kb_ * 32) * 2u)), (PG8_LAS unsigned*)(d_ + 8192 + (wid * 2) * 1024 + 1024), 16, 0, 0); } while (0)
        {   PG8_GADDR();
            PG8_GISSUE(0);
            if (wid < 4) __builtin_amdgcn_global_load_lds((const unsigned*)(gain + u.pn * BM + wid * 64 + lane), (PG8_LAS unsigned*)(lb + GTAB + wid * 256), 4, 0, 0);
            else if (wid < 6) __builtin_amdgcn_global_load_lds((const unsigned*)(b_s + h * 128 + (wid - 4) * 64 + lane), (PG8_LAS unsigned*)(lb + GTAB + 1024 + (wid - 4) * 256), 4, 0, 0);
            PG8_GISSUE(1); PG8_GISSUE(2); }
        __builtin_amdgcn_sched_barrier(0);
        norm_prepass<false>(acc, tabs + buf * 2048, 1.0f / 2048.0f, 1e-6f, wr, wc, fr, fq);
        __builtin_amdgcn_sched_barrier(0);
        asm volatile("" : "+v"(fr), "+v"(fq));
        PG8_GADDR();
        const int rwo = (4 * wr) * 1024 + lane * 16, rvo = 8192 + (wc * 2) * 1024 + lane * 16;
        f32x4 mx[2][4][2];
#define PG8_GGELU(ai, kb, q) do { constexpr int bjg_ = (kb) >> 1, mg_ = 2 * ((kb) & 1) + ((q) >> 1), ng_ = (q) & 1; acc[ai][bjg_][mg_][ng_] = gelu4(acc[ai][bjg_][mg_][ng_]); asm volatile("" : "+v"(acc[ai][bjg_][mg_][ng_])); } while (0)
#define PG8_GMMA(m, W) do { _Pragma("unroll") for (int bj = 0; bj < 2; ++bj) { mx[bj][m][0] = __builtin_amdgcn_mfma_f32_16x16x32_bf16(vtf[bj][0], W, mx[bj][m][0], 0, 0, 0); \
                                                                            mx[bj][m][1] = __builtin_amdgcn_mfma_f32_16x16x32_bf16(vtf[bj][1], W, mx[bj][m][1], 0, 0, 0); } } while (0)
#define PG8_GSTEP(k, WAITN) do { constexpr int ai = (k) >> 2, kb = (k) & 3; \
            asm volatile("s_waitcnt lgkmcnt(0)" ::: "memory"); asm volatile("s_waitcnt vmcnt(" #WAITN ")" ::: "memory"); __builtin_amdgcn_s_barrier(); asm volatile("" ::: "memory"); \
            if ((k) >= 1 && (k) + 2 <= 7) PG8_GISSUE(((k) >= 1 && (k) + 2 <= 7) ? (k) + 2 : 7); __builtin_amdgcn_sched_barrier(0); \
            if (kb == 0) { _Pragma("unroll") for (int bj = 0; bj < 2; ++bj) _Pragma("unroll") for (int m = 0; m < 4; ++m) { mx[bj][m][0] = (f32x4){0.f, 0.f, 0.f, 0.f}; mx[bj][m][1] = (f32x4){0.f, 0.f, 0.f, 0.f}; } } \
            { const PG8_LAS unsigned char* rw = lb + PG8_GSB(k) + rwo; const PG8_LAS unsigned char* rv = lb + PG8_GSB(k) + rvo; \
              bf16x8 vtf[2][2], wsfA, wsfB; \
              _Pragma("unroll") for (int bj = 0; bj < 2; ++bj) { vtf[bj][0] = *(const PG8_LAS bf16x8*)(rv + bj * 8192); vtf[bj][1] = *(const PG8_LAS bf16x8*)(rv + bj * 8192 + 1024); } \
              wsfA = *(const PG8_LAS bf16x8*)(rw); __builtin_amdgcn_sched_barrier(0); \
              PG8_GGELU(ai, kb, 0); __builtin_amdgcn_sched_barrier(0); \
              wsfB = *(const PG8_LAS bf16x8*)(rw + 1024); PG8_GMMA(0, wsfA); PG8_GGELU(ai, kb, 1); __builtin_amdgcn_sched_barrier(0); \
              wsfA = *(const PG8_LAS bf16x8*)(rw + 2048); PG8_GMMA(1, wsfB); PG8_GGELU(ai, kb, 2); __builtin_amdgcn_sched_barrier(0); \
              wsfB = *(const PG8_LAS bf16x8*)(rw + 3072); PG8_GMMA(2, wsfA); PG8_GGELU(ai, kb, 3); __builtin_amdgcn_sched_barrier(0); \
              PG8_GMMA(3, wsfB); } \
            __builtin_amdgcn_sched_barrier(0); \
            if (kb == 3) {     \
                f32x4 gv[2][2]; \
                _Pragma("unroll") for (int bj = 0; bj < 2; ++bj) { gv[bj][0] = *(const PG8_LAS f32x4*)(lb + GTAB + (wc * 32 + 8 * fq + bj * HALF) * 4); gv[bj][1] = *(const PG8_LAS f32x4*)(lb + GTAB + (wc * 32 + 8 * fq + bj * HALF) * 4 + 16); } \
                _Pragma("unroll") for (int m = 0; m < 4; ++m) { const int p = wr * 64 + m * 16 + fr; const float bsv = *(const PG8_LAS float*)(lb + GTAB + 1024 + p * 4); \
                    bf16_t* rowp = Gt + (size_t)(u.pm * BM + ai * HALF + p) * ldc + u.pn * BM + wc * 32 + 8 * fq; \
                    _Pragma("unroll") for (int bj = 0; bj < 2; ++bj) { const f32x4 v0 = acc[ai][bj][m][0] * (mx[bj][m][0] * gv[bj][0] + bsv), v1 = acc[ai][bj][m][1] * (mx[bj][m][1] * gv[bj][1] + bsv); \
                        u32x4 w; w.x = cvt_pk_bf16(v0[0], v0[1]); w.y = cvt_pk_bf16(v0[2], v0[3]); w.z = cvt_pk_bf16(v1[0], v1[1]); w.w = cvt_pk_bf16(v1[2], v1[3]); \
                        *(u32x4*)(rowp + bj * HALF) = w; } } \
                __builtin_amdgcn_sched_barrier(0); } } while (0)
        PG8_GSTEP(0, 6); PG8_GSTEP(1, 3); PG8_GSTEP(2, 3); PG8_GSTEP(3, 3); PG8_GSTEP(4, 11); PG8_GSTEP(5, 11); PG8_GSTEP(6, 3); PG8_GSTEP(7, 0);
        asm volatile("s_waitcnt lgkmcnt(0)" ::: "memory"); __builtin_amdgcn_s_barrier(); asm volatile("" ::: "memory");
#undef PG8_GSTEP
#undef PG8_GMMA
#undef PG8_GGELU
#undef PG8_GISSUE
#undef PG8_GADDR
#undef PG8_GSB
    }
};

struct EpiResid {
    static constexpr bool PERM = true, PREF = false, RESTAGE = false;
    bf16_t* X; int ldc; const float* gate; int gstride; bf16_t* XS; const float* gsn; int gsstride; float* ssn; const float* xin0; const float* xin1;
    __device__ __forceinline__ void prefetch(const Unit&, int, int) const {}
    __device__ __forceinline__ void operator()(f32x4 (&acc)[2][2][4][2], const Unit& u, int wr, int wc, int fr, int fq, int) const {
        const int row0 = u.pm * BM + wr * 64 + fr, col0 = u.pn * BM + wc * 32 + 8 * fq;
        const int b = batch_of_tile(u.pm);
        const float* gp = gate + (size_t)b * gstride + col0;
        int ln = fq * 16 + fr; asm volatile("" : "+v"(ln));
        f32x4 gv[2][2], sv[2][2];
#pragma unroll
        for (int bj = 0; bj < 2; ++bj) { gv[bj][0] = *(const f32x4*)(gp + bj * HALF); gv[bj][1] = *(const f32x4*)(gp + bj * HALF + 4); }
        if (XS) { const float* sp_ = gsn + (size_t)b * gsstride + col0;
#pragma unroll
            for (int bj = 0; bj < 2; ++bj) { sv[bj][0] = *(const f32x4*)(sp_ + bj * HALF); sv[bj][1] = *(const f32x4*)(sp_ + bj * HALF + 4); } }
#pragma unroll
        for (int ai = 0; ai < 2; ++ai)
#pragma unroll
            for (int mp = 0; mp < 2; ++mp) {
                f32x4 xx[2][2][2];
#pragma unroll
                for (int mm = 0; mm < 2; ++mm) { const int rrow = row0 + ai * HALF + (2 * mp + mm) * 16;
                    if (xin0) { const float* rowp = (u.pm < 64 ? xin0 + (size_t)rrow * ldc : xin1 + (size_t)(rrow - 16384) * ldc) + col0;
#pragma unroll
                        for (int bj = 0; bj < 2; ++bj) { xx[mm][bj][0] = *(const f32x4*)(rowp + bj * HALF); xx[mm][bj][1] = *(const f32x4*)(rowp + bj * HALF + 4); } }
                    else { const bf16_t* rowp = X + (size_t)rrow * ldc + col0;
#pragma unroll
                        for (int bj = 0; bj < 2; ++bj) { const u32x4 w = *(const u32x4*)(rowp + bj * HALF);
                            xx[mm][bj][0] = (f32x4){__builtin_bit_cast(float, w.x << 16), __builtin_bit_cast(float, w.x & 0xffff0000u), __builtin_bit_cast(float, w.y << 16), __builtin_bit_cast(float, w.y & 0xffff0000u)};
                            xx[mm][bj][1] = (f32x4){__builtin_bit_cast(float, w.z << 16), __builtin_bit_cast(float, w.z & 0xffff0000u), __builtin_bit_cast(float, w.w << 16), __builtin_bit_cast(float, w.w & 0xffff0000u)}; } } }
#pragma unroll
                for (int mm = 0; mm < 2; ++mm) { const int m = 2 * mp + mm, row = row0 + ai * HALF + m * 16; float ssq = 0.f;
#pragma unroll
                    for (int bj = 0; bj < 2; ++bj) { const f32x4 x0 = xx[mm][bj][0] + gv[bj][0] * acc[ai][bj][m][0], x1 = xx[mm][bj][1] + gv[bj][1] * acc[ai][bj][m][1];
                        u32x4 xw; xw.x = cvt_pk_bf16(x0[0], x0[1]); xw.y = cvt_pk_bf16(x0[2], x0[3]); xw.z = cvt_pk_bf16(x1[0], x1[1]); xw.w = cvt_pk_bf16(x1[2], x1[3]);
                        *(u32x4*)(X + (size_t)row * ldc + col0 + bj * HALF) = xw;
                        if (XS) { ssq += ((x0[0] * x0[0] + x0[1] * x0[1]) + (x0[2] * x0[2] + x0[3] * x0[3])) + ((x1[0] * x1[0] + x1[1] * x1[1]) + (x1[2] * x1[2] + x1[3] * x1[3]));
                            const f32x4 y0 = x0 * sv[bj][0], y1 = x1 * sv[bj][1];
                            u32x4 w; w.x = cvt_pk_bf16(y0[0], y0[1]); w.y = cvt_pk_bf16(y0[2], y0[3]); w.z = cvt_pk_bf16(y1[0], y1[1]); w.w = cvt_pk_bf16(y1[2], y1[3]);
                            *(u32x4*)(XS + (size_t)row * ldc + col0 + bj * HALF) = w; } }
                    if (XS) { ssq += shfl_xor_l(ssq, 16, ln); ssq += shfl_xor_l(ssq, 32, ln); if (fq == 0) atomicAdd((unsigned*)ssn + row, (unsigned)(ssq * SSQ_SCALE + 0.5f)); } }
                asm volatile("" ::: "memory"); }
    }
};

template <class Epi, class Sched, bool ALIGN_EPI>
__device__ __forceinline__ void gemm_phase(PG8_LAS unsigned char* lds, const Gemm g, const Sched& S, const Epi& E, const int wave_s) {
    int wid_ = wave_s; asm volatile("" : "+s"(wid_));
    const int wid = wid_, wr = wid >> 2, wc = wid & 3;
    const int K = g.K, nt = K / BK;
    unsigned voffA[2], voffB[2]; int aoff, boff;
#define PG8_LANE_SETUP() do { const int lane_ = lane_asm(), tid_ = wid * 64 + lane_, fr_ = lane_ & 15, fq_ = lane_ >> 4; \
        _Pragma("unroll") for (int i = 0; i < 2; ++i) { int R, C; stage_rc(tid_ * 16 + i * 8192, R, C); const int Rb = Epi::PERM ? ((R & ~31) + perm32(R & 31)) : R; \
            voffA[i] = (unsigned)(R * g.lda + C) * 2u; voffB[i] = (unsigned)(Rb * g.ldb + C) * 2u; } \
        aoff = lds_byte(wr * 64 + fr_, fq_ * 8); boff = lds_byte(wc * 32 + fr_, fq_ * 8); } while (0)
    PG8_LANE_SETUP();
    const size_t kstep = (size_t)(BK * 2);
    const size_t hstepA = (size_t)HALF * g.lda * 2, hstepB = (size_t)HALF * g.ldb * 2;
    const size_t tstepA = 2 * hstepA, tstepB = 2 * hstepB;
    const unsigned ldsw = (unsigned)wid * 1024u;
#define PG8_ABASE(u) ((const char*)g.A + (size_t)(u).pm * tstepA + (size_t)(((u).pn >> g.a_kshift) * g.a_kcols) * 2)
#define PG8_BBASE(u) ((const char*)g.Bt + (size_t)(u).pn * tstepB)
#define PG8_SA(b, h) (((b) * 2 + (h)) * HTB)
#define PG8_SB(b, h) ((4 + (b) * 2 + (h)) * HTB)
#define PG8_STAGE(bufoff, gbase, voff) do { _Pragma("unroll") for (int _i = 0; _i < 2; ++_i) \
        __builtin_amdgcn_global_load_lds((const unsigned*)((const char*)(gbase) + (voff)[_i]), (PG8_LAS unsigned*)(lds + (bufoff) + ldsw + _i * 8192), 16, 0, 0); } while (0)
#define PG8_LDA(dst, b, h) do { _Pragma("unroll") for (int m = 0; m < 4; ++m) _Pragma("unroll") for (int k = 0; k < 2; ++k) dst[m][k] = *(const PG8_LAS bf16x8*)(lds + PG8_SA(b, h) + aoff + m * 2048 + k * 1024); } while (0)
#define PG8_LDB(dst, b, h) do { _Pragma("unroll") for (int n = 0; n < 2; ++n) _Pragma("unroll") for (int k = 0; k < 2; ++k) dst[n][k] = *(const PG8_LAS bf16x8*)(lds + PG8_SB(b, h) + boff + n * 2048 + k * 1024); } while (0)
#define PG8_MMA(ai, bj, At, Bt) do { __builtin_amdgcn_s_setprio(1); _Pragma("unroll") for (int m = 0; m < 4; ++m) _Pragma("unroll") for (int n = 0; n < 2; ++n) _Pragma("unroll") for (int k = 0; k < 2; ++k) \
        acc[ai][bj][m][n] = __builtin_amdgcn_mfma_f32_16x16x32_bf16(Bt[n][k], At[m][k], acc[ai][bj][m][n], 0, 0, 0); __builtin_amdgcn_s_setprio(0); } while (0)
#define PG8_MMA_HEAD(ai, At, B0_) do { __builtin_amdgcn_s_setprio(1); _Pragma("unroll") for (int k = 0; k < 2; ++k) \
        acc[ai][0][0][0] = __builtin_amdgcn_mfma_f32_16x16x32_bf16(B0_[0][k], At[0][k], acc[ai][0][0][0], 0, 0, 0); } while (0)
#define PG8_MMA_TAIL(ai, At, B0_, B1_) do { _Pragma("unroll") for (int k = 0; k < 2; ++k) acc[ai][0][0][1] = __builtin_amdgcn_mfma_f32_16x16x32_bf16(B0_[1][k], At[0][k], acc[ai][0][0][1], 0, 0, 0); \
        _Pragma("unroll") for (int m = 1; m < 4; ++m) _Pragma("unroll") for (int n = 0; n < 2; ++n) _Pragma("unroll") for (int k = 0; k < 2; ++k) \
        acc[ai][0][m][n] = __builtin_amdgcn_mfma_f32_16x16x32_bf16(B0_[n][k], At[m][k], acc[ai][0][m][n], 0, 0, 0); \
        _Pragma("unroll") for (int m = 0; m < 4; ++m) _Pragma("unroll") for (int n = 0; n < 2; ++n) _Pragma("unroll") for (int k = 0; k < 2; ++k) \
        acc[ai][1][m][n] = __builtin_amdgcn_mfma_f32_16x16x32_bf16(B1_[n][k], At[m][k], acc[ai][1][m][n], 0, 0, 0); __builtin_amdgcn_s_setprio(0); } while (0)
#define PG8_WAIT_V(n) asm volatile("s_waitcnt vmcnt(" #n ")" ::: "memory")
#define PG8_WAIT_L(n) asm volatile("s_waitcnt lgkmcnt(" #n ")" ::: "memory")
#define PG8_BAR __builtin_amdgcn_s_barrier()
#define PG8_SCHED __builtin_amdgcn_sched_barrier(0)
    Unit cur, nxt; int ui = 0;
    if (!S.next(0, cur)) return;
    f32x4 acc[2][2][4][2];
#pragma unroll
    for (int a = 0; a < 2; ++a)
#pragma unroll
        for (int b = 0; b < 2; ++b)
#pragma unroll
            for (int m = 0; m < 4; ++m)
#pragma unroll
                for (int n = 0; n < 2; ++n) acc[a][b][m][n] = (f32x4){0.f, 0.f, 0.f, 0.f};
    bf16x8 At[4][2], B0[2][2], B1[2][2];
    const char* cA = PG8_ABASE(cur); const char* cB = PG8_BBASE(cur);
    S.a_ready(cur);
    if constexpr (Epi::PREF) E.prefetch(cur, wid, 0);
    PG8_STAGE(PG8_SB(0, 0), cB, voffB); PG8_STAGE(PG8_SB(0, 1), cB + hstepB, voffB); PG8_STAGE(PG8_SA(0, 0), cA, voffA); PG8_STAGE(PG8_SA(0, 1), cA + hstepA, voffA);
    if (wr == 1) PG8_BAR;
    PG8_WAIT_V(2); PG8_BAR;
    PG8_STAGE(PG8_SB(1, 0), cB + kstep, voffB); PG8_STAGE(PG8_SA(1, 0), cA + kstep, voffA); PG8_STAGE(PG8_SB(1, 1), cB + hstepB + kstep, voffB);
    PG8_WAIT_V(6); PG8_BAR;
    for (;;) {
        const bool has_next = S.next(ui + 1, nxt);
        const char* nA = has_next ? PG8_ABASE(nxt) : cA; const char* nB = has_next ? PG8_BBASE(nxt) : cB;
        for (int t = 0; t < nt; t += 2) {
            const bool last = (t == nt - 2);
            const char* a1 = cA + (size_t)(t + 1) * kstep;
            const char* a2 = last ? nA : cA + (size_t)(t + 2) * kstep; const char* b2 = last ? nB : cB + (size_t)(t + 2) * kstep;
            const char* a3 = a2 + kstep; const char* b3 = b2 + kstep;
            if (last && has_next) S.a_ready(nxt);
            PG8_LDB(B0, 0, 0); PG8_LDB(B1, 0, 1); PG8_SCHED; PG8_LDA(At, 0, 0); PG8_STAGE(PG8_SA(1, 1), a1 + hstepA, voffA);
            PG8_WAIT_V(8); PG8_WAIT_L(0); PG8_MMA_HEAD(0, At, B0); PG8_SCHED; PG8_BAR; PG8_SCHED; PG8_MMA_TAIL(0, At, B0, B1); PG8_BAR; PG8_SCHED;
            PG8_LDA(At, 0, 1); PG8_STAGE(PG8_SB(0, 0), b2, voffB); PG8_STAGE(PG8_SB(0, 1), b2 + hstepB, voffB); PG8_STAGE(PG8_SA(0, 0), a2, voffA);
            PG8_WAIT_V(8); PG8_WAIT_L(0); PG8_MMA_HEAD(1, At, B0); PG8_SCHED; PG8_BAR; PG8_SCHED; PG8_MMA_TAIL(1, At, B0, B1); PG8_BAR; PG8_SCHED;
            PG8_LDB(B0, 1, 0); PG8_LDB(B1, 1, 1); PG8_SCHED; PG8_LDA(At, 1, 0); PG8_STAGE(PG8_SA(0, 1), a2 + hstepA, voffA);
            PG8_WAIT_V(8); PG8_WAIT_L(0); PG8_MMA_HEAD(0, At, B0); PG8_SCHED; PG8_BAR; PG8_SCHED; PG8_MMA_TAIL(0, At, B0, B1); PG8_BAR; PG8_SCHED;
            PG8_LDA(At, 1, 1); if (!(Epi::RESTAGE && last)) { PG8_STAGE(PG8_SB(1, 0), b3, voffB); PG8_STAGE(PG8_SB(1, 1), b3 + hstepB, voffB); PG8_STAGE(PG8_SA(1, 0), a3, voffA); }
            PG8_WAIT_V(8); PG8_WAIT_L(0); PG8_MMA_HEAD(1, At, B0); PG8_SCHED; PG8_BAR; PG8_SCHED; PG8_MMA_TAIL(1, At, B0, B1); PG8_BAR; PG8_SCHED;
        }
        if constexpr (ALIGN_EPI) { if (wr == 0) PG8_BAR; }
        if constexpr (Epi::PREF && Epi::RESTAGE) { if (has_next) E.prefetch(nxt, wid, (ui + 1) & 1); }
        if constexpr (Epi::RESTAGE) { if (ui == 0) E.late_wait(wid); }
        { const int lane_e = lane_asm(); E(acc, cur, wr, wc, lane_e & 15, lane_e >> 4, ui & 1); } S.done(cur);
        if constexpr (Epi::PREF && !Epi::RESTAGE) { if (has_next) E.prefetch(nxt, wid, (ui + 1) & 1); }
        if (!has_next) break;
#pragma unroll
        for (int a = 0; a < 2; ++a)
#pragma unroll
            for (int b = 0; b < 2; ++b)
#pragma unroll
                for (int m = 0; m < 4; ++m)
#pragma unroll
                    for (int n = 0; n < 2; ++n) acc[a][b][m][n] = (f32x4){0.f, 0.f, 0.f, 0.f};
        cur = nxt; cA = nA; cB = nB; ++ui;
        PG8_LANE_SETUP();
        if constexpr (Epi::RESTAGE) { PG8_STAGE(PG8_SB(1, 0), cB + kstep, voffB); PG8_STAGE(PG8_SB(1, 1), cB + hstepB + kstep, voffB); PG8_STAGE(PG8_SA(1, 0), cA + kstep, voffA); }
        if constexpr (ALIGN_EPI) { if (wr == 1) PG8_BAR; }
    }
    PG8_WAIT_V(0);
    if constexpr (!ALIGN_EPI) { if (wr == 0) PG8_BAR; }
    PG8_BAR;
#undef PG8_LANE_SETUP
#undef PG8_ABASE
#undef PG8_BBASE
#undef PG8_SA
#undef PG8_SB
#undef PG8_STAGE
#undef PG8_LDA
#undef PG8_LDB
#undef PG8_MMA
#undef PG8_MMA_HEAD
#undef PG8_MMA_TAIL
#undef PG8_WAIT_V
#undef PG8_WAIT_L
#undef PG8_BAR
#undef PG8_SCHED
}
}

constexpr int NWAVES = 8;
constexpr int D = 2048, T = 32768, DEPTH = 4, NBATCH = 3;
constexpr int FF = 8192, SFF = 12288, SHALF = 6144, NHEADS = 8, HDIM = 768, CHUNK = 128, NMOD = 6, PGRP = 512;
constexpr int VTLD = T + 64;
constexpr int NSSP = 48;
constexpr float EPS = 1e-6f;

constexpr size_t MiB = 1u << 20;
constexpr size_t WS_CTL = 0, CTL_ZERO_BYTES = 57344;
constexpr size_t WS_MODV = 1 * MiB;
constexpr size_t WS_SSP = 2 * MiB;
constexpr size_t WS_WPIN = 8 * MiB;
constexpr size_t WS_WPGRP = 24 * MiB;
constexpr size_t WS_WPOUT = 28 * MiB;
constexpr size_t WS_WSIN = 44 * MiB;
constexpr size_t WS_WSOUT = 140 * MiB;
constexpr size_t WS_W1 = 188 * MiB;
constexpr size_t WS_W2 = 316 * MiB;
constexpr size_t WS_H = 444 * MiB;
constexpr size_t WS_BIG = 572 * MiB;
constexpr size_t WS_WSS = 1341 * MiB;
constexpr size_t WS_SSX = 1405 * MiB;
constexpr size_t SSX_BYTES = (size_t)9 * 32768 * 4;
constexpr size_t WS_GS = 64 * 1024;
constexpr size_t WS_CVM = 1407 * MiB;
constexpr size_t WS_CV1 = 1 * MiB + 640 * 1024;
constexpr size_t WS_XB = 1408 * MiB;
constexpr size_t WS_END = 1536 * MiB;
constexpr int CW_BAR = 4096;

#define LAS __attribute__((address_space(3)))
typedef unsigned short bf16;
typedef unsigned v4u __attribute__((ext_vector_type(4)));
typedef unsigned v2u __attribute__((ext_vector_type(2)));
typedef float f32x4 __attribute__((ext_vector_type(4)));
typedef short bf16x8 __attribute__((ext_vector_type(8)));
#define LDS_WAIT() asm volatile("s_waitcnt lgkmcnt(0)" ::: "memory")
__device__ __forceinline__ unsigned f2bf(float f) { unsigned u = __builtin_bit_cast(unsigned, f); return (u + 0x7fffu + ((u >> 16) & 1u)) >> 16; }
__device__ __forceinline__ unsigned pk2(float lo, float hi) { return f2bf(lo) | (f2bf(hi) << 16); }
__device__ __forceinline__ float bflo(unsigned w) { return __builtin_bit_cast(float, w << 16); }
__device__ __forceinline__ float bfhi(unsigned w) { return __builtin_bit_cast(float, w & 0xffff0000u); }

#define XB_TMO      128
#define XB_XCNT(j)  (256  + 64 * (j))
#define XB_XSUB(j)  (1280 + 64 * (j))
#define XB_XGEN(j)  (2304 + 64 * (j))
#define XB_TOP      3328
#define XB_TOPGEN   3392
#define XCD_BAR_WORDS 3456
#define XB_XSUB2(j) (3456 + 64 * (j))
#define XB_TOP2     4480
#define XB_TOPGEN2  4544
#define XB_XGEN2(j) (4608 + 64 * (j))
#define XB_LSUB(j)  (7808 + 64 * (j))
#define XB_LGEN(j)  (8832 + 64 * (j))
#define XB_SET(s)   ((s) * 2176u)
#define XB_SPIN_CAP (1u << 18)

__device__ __forceinline__ unsigned xb_ld(unsigned* p)              { return __hip_atomic_load(p, __ATOMIC_RELAXED, __HIP_MEMORY_SCOPE_AGENT); }
__device__ __forceinline__ unsigned xb_add(unsigned* p, unsigned v) { return __hip_atomic_fetch_add(p, v, __ATOMIC_RELAXED, __HIP_MEMORY_SCOPE_AGENT); }
__device__ __forceinline__ unsigned xb_xcc_id() { return (unsigned)__builtin_amdgcn_s_getreg((3 << 11) | 20) & 0xFu; }
#define XB_SPIN(cond, bar) do { unsigned _sp = 0; while (cond) { __builtin_amdgcn_s_sleep(1); \
    if ((++_sp & 255u) == 0u) { if (xb_ld(&(bar)[XB_TMO])) break; if (_sp > XB_SPIN_CAP) { atomicAdd(&(bar)[XB_TMO], 1u); break; } } } } while (0)

struct XcdBarrier {
    unsigned* bar; unsigned x;
    volatile LAS unsigned* st;
};
__device__ __forceinline__ XcdBarrier xcd_barrier_post(unsigned* bar, volatile LAS unsigned* st) {
    XcdBarrier b; b.bar = bar; b.x = xb_xcc_id(); b.st = st;
    if (threadIdx.x == 0) { const unsigned rank = xb_add(&bar[XB_XCNT(b.x)], 1u); st[2] = rank; st[3] = b.x; }
    return b;
}
__device__ __forceinline__ void xcd_barrier_complete(unsigned* bar, unsigned x, unsigned& nloc, unsigned& nx) {
    const unsigned G = gridDim.x * gridDim.y * gridDim.z;
    unsigned sum, cnt, mine, sp = 0u;
    for (;;) {
        sum = 0u; cnt = 0u; mine = 0u;
#pragma unroll
        for (unsigned j = 0; j < 16; ++j) { const unsigned c = xb_ld(&bar[XB_XCNT(j)]); sum += c; cnt += (c > 0u) ? 1u : 0u; mine = (j == x) ? c : mine; }
        if (sum == G) break;
        __builtin_amdgcn_s_sleep(1);
        if ((++sp & 255u) == 0u) { if (xb_ld(&bar[XB_TMO])) break; if (sp > XB_SPIN_CAP) { atomicAdd(&bar[XB_TMO], 1u); break; } }
    }
    nloc = mine > 0u ? mine : 1u; nx = cnt > 0u ? cnt : 1u;
}
__device__ __forceinline__ void xcd_barrier(const XcdBarrier& b, const int wave_s) {
    asm volatile("s_waitcnt vmcnt(0)" ::: "memory");
    __syncthreads();
    if (wave_s == 0 && pg8::lane_asm() == 0) {
        unsigned* bar = b.bar; asm volatile("" : "+s"(bar));
        __builtin_amdgcn_s_waitcnt(0);
        const unsigned bx_ = xb_xcc_id();
        unsigned nloc = b.st[0], nx = b.st[1];
        if (nloc == 0u) { xcd_barrier_complete(bar, bx_, nloc, nx); b.st[0] = nloc; b.st[1] = nx; }
        const unsigned old = xb_add(&bar[XB_XSUB(bx_)], 1u);
        const unsigned gen = old / nloc;
        if (old + 1u == (gen + 1u) * nloc) {
            __builtin_amdgcn_fence(__ATOMIC_RELEASE, "agent");
            asm volatile("s_waitcnt vmcnt(0)" ::: "memory");
            const unsigned og = xb_add(&bar[XB_TOP], 1u);
            const unsigned tg = og / nx;
            if (og + 1u == (tg + 1u) * nx) xb_add(&bar[XB_TOPGEN], 1u);
            else XB_SPIN(xb_ld(&bar[XB_TOPGEN]) == tg, bar);
            __builtin_amdgcn_fence(__ATOMIC_ACQUIRE, "agent");
            xb_add(&bar[XB_XGEN(bx_)], 1u);
            asm volatile("s_waitcnt vmcnt(0)" ::: "memory");
        } else {
            XB_SPIN(xb_ld(&bar[XB_XGEN(bx_)]) == gen, bar);
            __builtin_amdgcn_fence(__ATOMIC_ACQUIRE, "agent");
            asm volatile("s_waitcnt vmcnt(0)" ::: "memory");
        }
    }
    __syncthreads();
}
__device__ __forceinline__ void xcd_local_barrier(const XcdBarrier& b, const int wave_s) {
    asm volatile("s_waitcnt vmcnt(0)" ::: "memory");
    __syncthreads();
    if (wave_s == 0 && pg8::lane_asm() == 0) {
        unsigned* bar = b.bar; asm volatile("" : "+s"(bar));
        __builtin_amdgcn_s_waitcnt(0);
        const unsigned bx_ = xb_xcc_id();
        const unsigned nloc = b.st[0];
        const unsigned old = xb_add(&bar[XB_LSUB(bx_)], 1u);
        const unsigned gen = old / nloc;
        if (old + 1u == (gen + 1u) * nloc) xb_add(&bar[XB_LGEN(bx_)], 1u);
        else XB_SPIN(xb_ld(&bar[XB_LGEN(bx_)]) == gen, bar);
        __builtin_amdgcn_fence(__ATOMIC_ACQUIRE, "agent");
        asm volatile("s_waitcnt vmcnt(0)" ::: "memory");
    }
    __syncthreads();
}
__device__ __forceinline__ void xcd_arrive2(const XcdBarrier& b, const int wave_s, const unsigned setoff = 0u) {
    asm volatile("s_waitcnt vmcnt(0)" ::: "memory");
    __syncthreads();
    if (wave_s == 0 && pg8::lane_asm() == 0) {
        unsigned* bar = b.bar; asm volatile("" : "+s"(bar));
        __builtin_amdgcn_s_waitcnt(0);
        const unsigned bx_ = xb_xcc_id();
        unsigned nloc = b.st[0], nx = b.st[1];
        if (nloc == 0u) { xcd_barrier_complete(bar, bx_, nloc, nx); b.st[0] = nloc; b.st[1] = nx; }
        const unsigned old = xb_add(&bar[setoff + XB_XSUB2(bx_)], 1u);
        const unsigned gen = old / nloc;
        if (old + 1u == (gen + 1u) * nloc) {
            __builtin_amdgcn_fence(__ATOMIC_RELEASE, "agent");
            asm volatile("s_waitcnt vmcnt(0)" ::: "memory");
            const unsigned og = xb_add(&bar[setoff + XB_TOP2], 1u);
            const unsigned tg = og / nx;
            if (og + 1u == (tg + 1u) * nx) {
                xb_add(&bar[setoff + XB_TOPGEN2], 1u);
#pragma unroll
                for (unsigned jx = 0; jx < 16; ++jx) xb_add(&bar[setoff + XB_XGEN2(jx)], 1u);
            }
            asm volatile("s_waitcnt vmcnt(0)" ::: "memory");
        }
    }
}
__device__ __forceinline__ void xcd_wait2(unsigned* bar_, unsigned target, int wid, unsigned setoff) {
    if (wid == 0 && pg8::lane_asm() == 0) {
        unsigned* bar = bar_; asm volatile("" : "+s"(bar));
        const unsigned bx_ = xb_xcc_id();
        XB_SPIN(xb_ld(&bar[setoff + XB_XGEN2(bx_)]) < target, bar);
        __builtin_amdgcn_fence(__ATOMIC_ACQUIRE, "agent");
        asm volatile("s_waitcnt vmcnt(0)" ::: "memory");
    }
    asm volatile("" ::: "memory"); __builtin_amdgcn_s_barrier(); asm volatile("" ::: "memory");
}

constexpr int RING_OFF = 0, RING_BYTES = 131072;
constexpr int SPARE_OFF = RING_BYTES, SPARE_BYTES = 24576;
constexpr int TAB_OFF = SPARE_OFF + SPARE_BYTES + 128;
constexpr int MISC_OFF = SPARE_OFF + SPARE_BYTES;
constexpr int LDS_BYTES = 163840;

__device__ __forceinline__ int opaque_s(int v) { asm volatile("" : "+s"(v)); return v; }
__device__ __forceinline__ int otid(int wave_s) { return wave_s * 64 + pg8::lane_asm(); }
__device__ __forceinline__ float wave_sum(float v, int lane) {
#pragma unroll
    for (int o = 1; o < 64; o <<= 1) v += pg8::shfl_xor_l(v, o, lane);
    return v;
}

__device__ __forceinline__ void p0_transpose_item(const float* W, int K, int N, bf16* WT, LAS float* scr, int item, int lane) {
    const int nblk = N / 32, kb = item / nblk, nb = item % nblk, k0 = 64 * kb, n0 = 32 * nb;
#pragma unroll 8
    for (int i = 0; i < 32; ++i) { const int kk = 2 * i + (lane >> 5); scr[kk * 33 + (lane & 31)] = __builtin_nontemporal_load(W + (size_t)(k0 + kk) * N + n0 + (lane & 31)); }
    LDS_WAIT(); asm volatile("" ::: "memory");
    const int c = lane & 7;
#pragma unroll
    for (int j = 0; j < 4; ++j) { const int n = (lane >> 3) + 8 * j; const LAS float* s = scr + (8 * c) * 33 + n;
        v4u o; o.x = pk2(s[0 * 33], s[1 * 33]); o.y = pk2(s[2 * 33], s[3 * 33]); o.z = pk2(s[4 * 33], s[5 * 33]); o.w = pk2(s[6 * 33], s[7 * 33]);
        *(v4u*)(WT + (size_t)(n0 + n) * K + k0 + 8 * c) = o; }
    LDS_WAIT(); asm volatile("" ::: "memory");
}
__device__ __forceinline__ void p0_scale_item(const float* Wg, const float* scale, bf16* WG, int item, int lane) {
    const int mat = item >> 7;
#pragma unroll
    for (int q = 0; q < 8; ++q) { const size_t idx = (size_t)item * 2048 + q * 256 + lane * 4; const int e = (int)(idx & 511);
        const f32x4 w = *(const f32x4*)(Wg + idx) * *(const f32x4*)(scale + mat * 512 + e);
        v2u o; o.x = pk2(w[0], w[1]); o.y = pk2(w[2], w[3]); *(v2u*)(WG + idx) = o; }
}
__device__ __forceinline__ bool p0_stack(int& it, const float* W, int L, int K, int N, bf16* WT, LAS float* scr, int lane) {
    const int per = (K / 64) * (N / 32), tot = L * per;
    if (it >= tot) { it -= tot; return false; }
    const int l = it / per, r = it % per;
    p0_transpose_item(W + (size_t)l * K * N, K, N, WT + (size_t)l * K * N, scr, r, lane);
    return true;
}

__device__ __forceinline__ void gemv3_item(const float* W, size_t ldw, int e0, const LAS float* vec, const float* bias, float* out, size_t ostride, LAS float* red, int tid, int lane, int wave) {
    const int r4 = lane >> 4, c4 = (lane & 15) * 4;
    const float* wp = W + (size_t)(wave * 256 + r4) * ldw + e0 + c4;
    f32x4 a0 = {0.f, 0.f, 0.f, 0.f}, a1 = a0, a2 = a0;
#pragma unroll 16
    for (int it = 0; it < 64; ++it) { const f32x4 w = __builtin_nontemporal_load((const f32x4*)(wp + (size_t)it * 4 * ldw)); const int d = wave * 256 + it * 4 + r4;
        a0 += w * vec[d]; a1 += w * vec[2048 + d]; a2 += w * vec[4096 + d]; }
#pragma unroll
    for (int j = 0; j < 4; ++j) { a0[j] += __shfl_xor(a0[j], 16); a0[j] += __shfl_xor(a0[j], 32); a1[j] += __shfl_xor(a1[j], 16); a1[j] += __shfl_xor(a1[j], 32); a2[j] += __shfl_xor(a2[j], 16); a2[j] += __shfl_xor(a2[j], 32); }
    if (lane < 16) { *(LAS f32x4*)(red + (wave * 3 + 0) * 64 + c4) = a0; *(LAS f32x4*)(red + (wave * 3 + 1) * 64 + c4) = a1; *(LAS f32x4*)(red + (wave * 3 + 2) * 64 + c4) = a2; }
    __syncthreads();
    if (tid < 192) { const int b = tid / 64, c = tid % 64; float sacc = bias ? bias[e0 + c] : 0.f;
#pragma unroll
        for (int w = 0; w < 8; ++w) sacc += red[(w * 3 + b) * 64 + c];
        out[(size_t)b * ostride + e0 + c] = sacc; }
    __syncthreads();
}

struct Args {
    const float* in[20]; float* out; unsigned char* ws; int ph_lo, ph_hi;
};

__global__ void __launch_bounds__(NWAVES * 64, 2) enc_fwd(Args args) {
    extern __shared__ __attribute__((aligned(16))) unsigned char lds_raw[];
    LAS unsigned char* lds = (LAS unsigned char*)lds_raw;
    volatile LAS unsigned* MISC = (volatile LAS unsigned*)(lds + MISC_OFF);
    const int tid = threadIdx.x, lane = tid & 63, wave = __builtin_amdgcn_readfirstlane(tid >> 6), wave_s = wave;
    const int G = gridDim.x, bx = blockIdx.x;
    unsigned char* ws = args.ws;
    unsigned* ctl = (unsigned*)(ws + WS_CTL);
    bf16* X = (bf16*)(ws + WS_XB);
    float* MODV = (float*)(ws + WS_MODV);
    float* SSP = (float*)(ws + WS_SSP);
    bf16* Hb = (bf16*)(ws + WS_H);
    bf16* BIG = (bf16*)(ws + WS_BIG);

    for (int u = tid; u < 32; u += NWAVES * 64) ((LAS unsigned*)(lds + MISC_OFF))[u] = 0u;
    __syncthreads();
#if MK_PER_PHASE_LAUNCH
#define GRID_BAR() do { } while (0)
#else
    XcdBarrier bar = xcd_barrier_post(ctl + CW_BAR, MISC + 8);
#define GRID_BAR() xcd_barrier(bar, wave_s)
#endif
#if MK_PER_PHASE_LAUNCH
    const int lo = args.ph_lo;
#define IN(k) (lo == (k))
#else
#define IN(k) true
#endif
    unsigned long long echo_last = ECHO_MASK ? __builtin_amdgcn_s_memrealtime() : 0ull, echo_acc = 0ull;
#define ECHO_TICK(k) do { if (ECHO_MASK) { const unsigned long long now_ = __builtin_amdgcn_s_memrealtime(); if ((ECHO_MASK >> (k)) & 1ull) echo_acc += now_ - echo_last; echo_last = now_; } } while (0)
#define SEAM(k) do { if (IN(k) && IN((k) + 1)) GRID_BAR(); ECHO_TICK(k); } while (0)

    float* SSX = (float*)(ws + WS_SSX); float* GS = (float*)(ws + WS_GS); float* CVM = (float*)(ws + WS_CVM); float* CV1 = (float*)(ws + WS_CV1);
    if (IN(0) && !SKIP_P0) {
        { const f32x4 z4 = {0.f, 0.f, 0.f, 0.f}; for (int u = bx * (NWAVES * 64) + tid; u < 8 * T / 4; u += G * (NWAVES * 64)) *(f32x4*)(SSX + T + (size_t)u * 4) = z4; }
        LAS float* cact = (LAS float*)(lds + RING_OFF);
        LAS float* red = (LAS float*)(lds + RING_OFF + 32768);
        for (int u = tid; u < NBATCH * D; u += NWAVES * 64) { const int b = u / D, d = u % D; const float c = (b < 2) ? args.in[2][b * D + d] : args.in[3][d]; cact[u] = c / (1.0f + __expf(-c)); }
        __syncthreads();
        for (int item = bx; item < DEPTH * (NMOD * D / 64); item += G) {
            const int i = item / (NMOD * D / 64), e0 = (item % (NMOD * D / 64)) * 64;
            gemv3_item(args.in[6] + (size_t)i * D * (NMOD * D), NMOD * D, e0, cact, args.in[7] + (size_t)i * (NMOD * D), MODV + (size_t)i * NBATCH * (NMOD * D), NMOD * D, red, tid, lane, wave);
        }
#if !MK_PER_PHASE_LAUNCH
        xcd_arrive2(bar, wave_s, XB_SET(1));
#endif
        LAS float* scr = (LAS float*)(lds + RING_OFF + wave * 16384);
        const int gw = bx * NWAVES + wave, NGW = G * NWAVES;
        constexpr int NITEMS = 2 * (D / 64) * (D / 32) * 2 + 8 * (PGRP / 64) * (PGRP / 32) + 2 * (D / 64) * (SFF / 32) + 2 * (SHALF / 64) * (D / 32) + 4 * (D / 64) * (FF / 32) + 4 * (FF / 64) * (D / 32);
        for (int it0 = gw; it0 < NITEMS; it0 += NGW) {
            int it = it0;
            if (p0_stack(it, args.in[8], 2, D, D, (bf16*)(ws + WS_WPIN), scr, lane)) continue;
            if (it < 8 * (PGRP / 64) * (PGRP / 32)) { p0_scale_item(args.in[9], args.in[10], (bf16*)(ws + WS_WPGRP), it, lane); continue; }
            it -= 8 * (PGRP / 64) * (PGRP / 32);
            if (p0_stack(it, args.in[11], 2, D, D, (bf16*)(ws + WS_WPOUT), scr, lane)) continue;
            if (p0_stack(it, args.in[17], 4, D, FF, (bf16*)(ws + WS_W1), scr, lane)) continue;
            if (p0_stack(it, args.in[18], 4, FF, D, (bf16*)(ws + WS_W2), scr, lane)) continue;
            if (p0_stack(it, args.in[12], 2, D, SFF, (bf16*)(ws + WS_WSIN), scr, lane)) continue;
            p0_stack(it, args.in[16], 2, SHALF, D, (bf16*)(ws + WS_WSOUT), scr, lane);
        }
        __syncthreads();
    }
#if MK_PER_PHASE_LAUNCH
    SEAM(0);
#else
    xcd_arrive2(bar, wave_s, 0u); __syncthreads(); ECHO_TICK(0);
#endif
    int vcu = bx, xl = 0;
#if !MK_PER_PHASE_LAUNCH
    {   bool ok = (G % 8) == 0; unsigned* bw = ctl + CW_BAR;
#pragma unroll
        for (int jx = 0; jx < 16; ++jx) { const unsigned cjx = xb_ld(&bw[XB_XCNT(jx)]); ok = ok && (cjx == (jx < 8 ? (unsigned)(G / 8) : 0u)); }
        const unsigned rk = MISC[10], xc = MISC[11];
        if (ok && xc < 8u && rk < (unsigned)(G / 8)) { vcu = (int)(rk * 8u + xc); xl = 1; }
        vcu = __builtin_amdgcn_readfirstlane(vcu); xl = __builtin_amdgcn_readfirstlane(xl);
    }
#endif
    if (IN(1) && !SKIP_P0) {
#if !MK_PER_PHASE_LAUNCH
        xcd_wait2(ctl + CW_BAR, 1u, wave_s, XB_SET(1));
#endif
        {
            const int gt = bx * (NWAVES * 64) + tid;
            if (gt < 8 * NBATCH * D) { const int r = gt / (NBATCH * D), b = (gt / D) % NBATCH, c = gt % D, li = r >> 1, sub = r & 1;
                GS[gt] = args.in[sub ? 5 : 4][(size_t)li * D + c] * (1.0f + MODV[((size_t)li * NBATCH + b) * (NMOD * D) + (sub ? 4 : 1) * D + c]); }
        }
        {
            LAS float* gs = (LAS float*)(lds + RING_OFF);
            for (int rb = bx; rb < T / 128; rb += G) {
                const int r0 = rb * 128, b = r0 < 8192 ? 0 : (r0 < 16384 ? 1 : 2);
                { const int c = tid * 4; const f32x4 gq = *(const f32x4*)(args.in[4] + c), sc = *(const f32x4*)(MODV + (size_t)b * (NMOD * D) + D + c); *(LAS f32x4*)(gs + c) = gq * (sc + 1.0f); }
                __syncthreads();
                for (int rr = 0; rr < 16; rr += 2) { const int row = r0 + wave * 16 + rr;
                    const float* src = row < 16384 ? args.in[0] + (size_t)row * D : args.in[1] + (size_t)(row - 16384) * D;
                    f32x4 v[2][8];
#pragma unroll
                    for (int h = 0; h < 2; ++h)
#pragma unroll
                        for (int q = 0; q < 4; ++q) { v[h][2 * q] = *(const f32x4*)(src + (size_t)h * D + q * 512 + lane * 8); v[h][2 * q + 1] = *(const f32x4*)(src + (size_t)h * D + q * 512 + lane * 8 + 4); }
#pragma unroll
                    for (int h = 0; h < 2; ++h) { float ss = 0.f;
#pragma unroll
                        for (int q = 0; q < 4; ++q) { const f32x4 x0 = v[h][2 * q], x1 = v[h][2 * q + 1];
                            ss += ((x0[0] * x0[0] + x0[1] * x0[1]) + (x0[2] * x0[2] + x0[3] * x0[3])) + ((x1[0] * x1[0] + x1[1] * x1[1]) + (x1[2] * x1[2] + x1[3] * x1[3]));
                            const f32x4 o0 = x0 * *(const LAS f32x4*)(gs + q * 512 + lane * 8), o1 = x1 * *(const LAS f32x4*)(gs + q * 512 + lane * 8 + 4);
                            v4u w; w.x = pk2(o0[0], o0[1]); w.y = pk2(o0[2], o0[3]); w.z = pk2(o1[0], o1[1]); w.w = pk2(o1[2], o1[3]); *(v4u*)(Hb + (size_t)(row + h) * D + q * 512 + lane * 8) = w; }
                        ss = wave_sum(ss, lane); if (lane == 0) ((unsigned*)SSX)[row + h] = (unsigned)(ss * pg8::SSQ_SCALE + 0.5f); } }
                __syncthreads(); }
        }
#if !MK_PER_PHASE_LAUNCH
        xcd_wait2(ctl + CW_BAR, 1u, wave_s, 0u);
#endif
        {
            LAS float* vec = (LAS float*)(lds + RING_OFF);
            const int gw = bx * NWAVES + wave, NGW = G * NWAVES;
            for (int hf = 0; hf < 2; ++hf) {
                __syncthreads();
                for (int u = tid; u < 4 * NBATCH * (D / 4); u += NWAVES * 64) { const int sx = u / (NBATCH * (D / 4)), r = u % (NBATCH * (D / 4)), b = r / (D / 4), d4 = r % (D / 4), id = hf * 4 + sx, li = id >> 1, which = id & 1;
                    *(LAS f32x4*)(vec + (size_t)u * 4) = *(const f32x4*)(MODV + ((size_t)li * NBATCH + b) * (NMOD * D) + (which ? 3 : 0) * D + d4 * 4); }
                __syncthreads();
                for (int sx = 0; sx < 4; ++sx) { const int id = hf * 4 + sx, li = id >> 1, which = id & 1;
                    const LAS float* vs = vec + sx * (NBATCH * D);
                    const int N = which ? FF : ((li & 1) ? SFF : D);
                    const bf16* Wt = which ? (const bf16*)(ws + WS_W1) + (size_t)li * FF * D : ((li & 1) ? (const bf16*)(ws + WS_WSIN) + (size_t)(li >> 1) * SFF * D : (const bf16*)(ws + WS_WPIN) + (size_t)(li >> 1) * D * D);
                    float* out = which ? CV1 + (size_t)li * NBATCH * FF : CVM + (size_t)li * NBATCH * SFF; const size_t ostride = which ? FF : SFF;
                    for (int n = gw; n < N; n += 2 * NGW) {
                        const int n2 = n + NGW; const bool two = n2 < N; const int n2c = two ? n2 : n;
                        v4u wA[4], wB[4];
#pragma unroll
                        for (int q = 0; q < 4; ++q) wA[q] = *(const v4u*)(Wt + (size_t)n * D + q * 512 + lane * 8);
#pragma unroll
                        for (int q = 0; q < 4; ++q) wB[q] = *(const v4u*)(Wt + (size_t)n2c * D + q * 512 + lane * 8);
                        float a0 = 0.f, a1 = 0.f, a2 = 0.f, b0 = 0.f, b1 = 0.f, b2 = 0.f;
#pragma unroll
                        for (int q = 0; q < 4; ++q) { const LAS float* vp = vs + q * 512 + lane * 8;
                            const float wf[8] = {bflo(wA[q].x), bfhi(wA[q].x), bflo(wA[q].y), bfhi(wA[q].y), bflo(wA[q].z), bfhi(wA[q].z), bflo(wA[q].w), bfhi(wA[q].w)};
                            const float wg[8] = {bflo(wB[q].x), bfhi(wB[q].x), bflo(wB[q].y), bfhi(wB[q].y), bflo(wB[q].z), bfhi(wB[q].z), bflo(wB[q].w), bfhi(wB[q].w)};
#pragma unroll
                            for (int e = 0; e < 8; ++e) { const float v0 = vp[e], v1 = vp[D + e], v2 = vp[2 * D + e]; a0 += wf[e] * v0; a1 += wf[e] * v1; a2 += wf[e] * v2; b0 += wg[e] * v0; b1 += wg[e] * v1; b2 += wg[e] * v2; } }
                        a0 = wave_sum(a0, lane); a1 = wave_sum(a1, lane); a2 = wave_sum(a2, lane); b0 = wave_sum(b0, lane); b1 = wave_sum(b1, lane); b2 = wave_sum(b2, lane);
                        if (lane == 0) { out[n] = a0; out[ostride + n] = a1; out[2 * ostride + n] = a2; if (two) { out[n2] = b0; out[ostride + n2] = b1; out[2 * ostride + n2] = b2; } }
                    }
                }
            }
            __syncthreads();
        }
        __syncthreads();
    }
    SEAM(1);

    for (int i = 0; i < DEPTH; ++i) {
        const int j = i >> 1, pb = 2 + i * 6;
        const float* modl = MODV + (size_t)i * NBATCH * (NMOD * D);
        const float* ss1 = SSX + (size_t)(2 * i) * T; float* ss2 = SSX + (size_t)(2 * i + 1) * T; float* ss3 = SSX + (size_t)(2 * i + 2) * T;
        const float* cvm = CVM + (size_t)i * NBATCH * SFF; const float* cv1 = CV1 + (size_t)i * NBATCH * FF;
        if ((i & 1) == 0) {
            bf16* Z = BIG + (size_t)640 * MiB / 2; bf16* ZD = BIG + (size_t)512 * MiB / 2; bf16* WO2 = (bf16*)(ws + WS_WSS);
            if (IN(pb + 0)) {
                pg8::Gemm g{Hb, (const bf16*)(ws + WS_WPIN) + (size_t)j * D * D, D, D, T, D, D, 0, 0}; pg8::StaticOrder S; S.init(T, D, G, opaque_s(vcu));
                pg8::EpiBf16<0, true> E{Z, D, nullptr, ss1, cvm, SFF, lds + TAB_OFF};
                pg8::gemm_phase<pg8::EpiBf16<0, true>, pg8::StaticOrder, true>(lds + RING_OFF, g, S, E, wave_s);
            }
#if MK_PER_PHASE_LAUNCH
            SEAM(pb + 0);
#else
            xcd_arrive2(bar, wave_s);
#endif
            if (IN(pb + 1) && !SKIP_POOL) {
                {
                    pg8::Gemm g{(const bf16*)(ws + WS_WPOUT) + (size_t)j * D * D, (const bf16*)(ws + WS_WPGRP) + (size_t)j * D * PGRP, D, PGRP, D, D, PGRP, 1, PGRP}; pg8::StaticOrder S; S.init(D, D, G, opaque_s(vcu));
                    pg8::EpiBf16<0, false> E{WO2, D, nullptr, nullptr, nullptr, 0, lds + TAB_OFF};
                    pg8::gemm_phase<pg8::EpiBf16<0, false>, pg8::StaticOrder, true>(lds + RING_OFF, g, S, E, wave_s);
                }
#if !MK_PER_PHASE_LAUNCH
                xcd_wait2(ctl + CW_BAR, (unsigned)(i + 2), wave_s); ECHO_TICK(pb + 0);
#endif
                const int tid = otid(wave_s);
                int bxo = bx; asm volatile("" : "+s"(bxo));
                for (int seg = bxo; seg < T / 128; seg += G) {
                    const int half = tid >> 8, chunk = tid & 255, gsel = chunk >> 6, hw = 1 << gsel;
                    const int r0 = seg * 128 + half * 64;
                    const int s0 = r0 < 8192 ? 0 : (r0 < 16384 ? 8192 : 16384), s1 = r0 < 8192 ? 8192 : (r0 < 16384 ? 16384 : 32768);
                    const bf16* zc = Z + chunk * 8; bf16* oc = ZD + chunk * 8;
                    float sum[8];
#pragma unroll
                    for (int q = 0; q < 8; ++q) sum[q] = 0.f;
                    for (int t = r0 - hw; t <= r0 + hw - 1; ++t) if (t >= s0 && t < s1) { const v4u w = *(const v4u*)(zc + (size_t)t * D);
                        sum[0] += bflo(w.x); sum[1] += bfhi(w.x); sum[2] += bflo(w.y); sum[3] += bfhi(w.y); sum[4] += bflo(w.z); sum[5] += bfhi(w.z); sum[6] += bflo(w.w); sum[7] += bfhi(w.w); }
#pragma unroll 8
                    for (int t = r0; t < r0 + 64; ++t) {
                        const int lo_t = (t - hw > s0) ? t - hw : s0, hi_t = (t + hw - 1 < s1 - 1) ? t + hw - 1 : s1 - 1;
                        const float inv = 1.0f / (float)(hi_t - lo_t + 1);
                        const v4u zc4 = *(const v4u*)(zc + (size_t)t * D);
                        v4u add = {0u, 0u, 0u, 0u}, sub = {0u, 0u, 0u, 0u};
                        if (t + hw < s1) add = *(const v4u*)(zc + (size_t)(t + hw) * D);
                        if (t - hw >= s0) sub = *(const v4u*)(zc + (size_t)(t - hw) * D);
                        v4u o;
                        o.x = pk2(sum[0] * inv - bflo(zc4.x), sum[1] * inv - bfhi(zc4.x)); o.y = pk2(sum[2] * inv - bflo(zc4.y), sum[3] * inv - bfhi(zc4.y));
                        o.z = pk2(sum[4] * inv - bflo(zc4.z), sum[5] * inv - bfhi(zc4.z)); o.w = pk2(sum[6] * inv - bflo(zc4.w), sum[7] * inv - bfhi(zc4.w));
                        *(v4u*)(oc + (size_t)t * D) = o;
                        sum[0] += bflo(add.x) - bflo(sub.x); sum[1] += bfhi(add.x) - bfhi(sub.x); sum[2] += bflo(add.y) - bflo(sub.y); sum[3] += bfhi(add.y) - bfhi(sub.y);
                        sum[4] += bflo(add.z) - bflo(sub.z); sum[5] += bfhi(add.z) - bfhi(sub.z); sum[6] += bflo(add.w) - bflo(sub.w); sum[7] += bfhi(add.w) - bfhi(sub.w);
                    }
                }
            }
            SEAM(pb + 1);
            if (IN(pb + 3)) {
                pg8::Gemm g{ZD, WO2, D, D, T, D, D, 0, 0}; pg8::StaticOrder S; S.init(T, D, G, opaque_s(vcu));
                pg8::EpiResid E{X, D, modl + 2 * D, NMOD * D, Hb, GS + (size_t)(2 * i + 1) * NBATCH * D, D, ss2, i == 0 ? args.in[0] : (const float*)nullptr, args.in[1]};
                pg8::gemm_phase<pg8::EpiResid, pg8::StaticOrder, true>(lds + RING_OFF, g, S, E, wave_s);
            }
#if MK_PER_PHASE_LAUNCH
            SEAM(pb + 3);
#else
            if (xl) xcd_local_barrier(bar, wave_s); else GRID_BAR(); ECHO_TICK(pb + 3);
#endif
        } else {
            bf16* Gt = BIG; bf16* VT = BIG + (size_t)T * SHALF; bf16* WsS = (bf16*)(ws + WS_WSS);
            const bf16* wsin = (const bf16*)(ws + WS_WSIN) + (size_t)j * SFF * D;
            if (IN(pb + 0)) {
                pg8::Gemm g{wsin + (size_t)SHALF * D, Hb, D, D, SHALF, T, D, 0, 0}; pg8::StaticOrder S; S.init(SHALF, T, G, opaque_s(vcu), 8);
                pg8::EpiVT E{VT, VTLD, SSP, T, ss1, cvm + SHALF, SFF, lds + TAB_OFF};
                pg8::gemm_phase<pg8::EpiVT, pg8::StaticOrder, true>(lds + RING_OFF, g, S, E, wave_s);
            }
            SEAM(pb + 0);
            if (IN(pb + 1) && !SKIP_GATE) {
                LAS float* rinv = (LAS float*)(lds + RING_OFF);
                const float* w_s = args.in[14] + (size_t)j * NHEADS * CHUNK * CHUNK;
                const int tid = otid(wave_s);
                int bxo = bx; asm volatile("" : "+s"(bxo));
                for (int n = bxo; n < T / CHUNK; n += G) {
                    if (tid < CHUNK) { float sacc = 0.f;
#pragma unroll
                        for (int k = 0; k < NSSP; ++k) sacc += SSP[(size_t)k * T + n * CHUNK + tid];
                        rinv[tid] = 1.0f / sqrtf(sacc * (1.0f / SHALF) + EPS); }
                    __syncthreads();
#pragma unroll 8
                    for (int it = 0; it < 32; ++it) { const int h = it >> 2, unit = (it & 3) * 512 + tid, p = unit >> 4, q8 = unit & 15;
                        const float* wp = w_s + (size_t)h * CHUNK * CHUNK + p * CHUNK + q8 * 8;
                        const f32x4 w0 = *(const f32x4*)wp * *(const LAS f32x4*)(rinv + q8 * 8), w1 = *(const f32x4*)(wp + 4) * *(const LAS f32x4*)(rinv + q8 * 8 + 4);
                        v4u o; o.x = pk2(w0[0], w0[1]); o.y = pk2(w0[2], w0[3]); o.z = pk2(w1[0], w1[1]); o.w = pk2(w1[2], w1[3]);
                        *(v4u*)(WsS + ((((size_t)(n * 8 + h) * 8 + (p >> 4)) * 4 + (q8 >> 2)) * 64 + (q8 & 3) * 16 + (p & 15)) * 8) = o; }
                    __syncthreads();
                }
            }
#if MK_PER_PHASE_LAUNCH
            SEAM(pb + 1);
#else
            xcd_arrive2(bar, wave_s); ECHO_TICK(pb + 1);
#endif
            if (IN(pb + 2)) {
                pg8::Gemm g{Hb, wsin, D, D, T, SHALF, D, 0, 0}; pg8::StaticOrder S; S.init(T, SHALF, G, opaque_s(vcu));
                pg8::EpiGate E{Gt, SHALF, VT, VTLD, WsS, args.in[13] + (size_t)j * SHALF, args.in[15] + (size_t)j * NHEADS * CHUNK, lds, ss1, cvm, SFF, lds + TAB_OFF, MK_PER_PHASE_LAUNCH ? (unsigned*)nullptr : ctl + CW_BAR, (unsigned)(i + 2)};
                pg8::gemm_phase<pg8::EpiGate, pg8::StaticOrder, true>(lds + RING_OFF, g, S, E, wave_s);
            }
#if MK_PER_PHASE_LAUNCH
            SEAM(pb + 2);
#else
            if (xl) xcd_local_barrier(bar, wave_s); else GRID_BAR(); ECHO_TICK(pb + 2);
#endif
            if (IN(pb + 3)) {
                pg8::Gemm g{Gt, (const bf16*)(ws + WS_WSOUT) + (size_t)j * D * SHALF, SHALF, SHALF, T, D, SHALF, 0, 0}; pg8::StaticOrder S; S.init(T, D, G, opaque_s(vcu), 4, 1);
                pg8::EpiResid E{X, D, modl + 2 * D, NMOD * D, Hb, GS + (size_t)(2 * i + 1) * NBATCH * D, D, ss2, nullptr, nullptr};
                pg8::gemm_phase<pg8::EpiResid, pg8::StaticOrder, true>(lds + RING_OFF, g, S, E, wave_s);
            }
            SEAM(pb + 3);
        }

        bf16* A2 = BIG;
        if (IN(pb + 4)) {
            pg8::Gemm g{Hb, (const bf16*)(ws + WS_W1) + (size_t)i * FF * D, D, D, T, FF, D, 0, 0}; pg8::StaticOrder S; S.init(T, FF, G, opaque_s(vcu));
            pg8::EpiBf16<2, true> E{A2, FF, nullptr, ss2, cv1, FF, lds + TAB_OFF};
            pg8::gemm_phase<pg8::EpiBf16<2, true>, pg8::StaticOrder, true>(lds + RING_OFF, g, S, E, wave_s);
        }
#if MK_PER_PHASE_LAUNCH
        SEAM(pb + 4);
#else
        if (xl) xcd_local_barrier(bar, wave_s); else GRID_BAR(); ECHO_TICK(pb + 4);
#endif
        if (IN(pb + 5)) {
            pg8::Gemm g{A2, (const bf16*)(ws + WS_W2) + (size_t)i * D * FF, FF, FF, T, D, FF, 0, 0}; pg8::StaticOrder S; S.init(T, D, G, opaque_s(vcu), 4, 1);
            pg8::EpiResid E{X, D, modl + 5 * D, NMOD * D, (i + 1 < DEPTH) ? Hb : (bf16*)nullptr, GS + (size_t)(2 * i + 2 < 8 ? 2 * i + 2 : 0) * NBATCH * D, D, ss3, nullptr, nullptr};
            pg8::gemm_phase<pg8::EpiResid, pg8::StaticOrder, true>(lds + RING_OFF, g, S, E, wave_s);
        }
#if MK_PER_PHASE_LAUNCH
        SEAM(pb + 5);
#else
        if (xl && (i == 1 || i == DEPTH - 1)) xcd_local_barrier(bar, wave_s); else GRID_BAR(); ECHO_TICK(pb + 5);
#endif
    }

    if (IN(2 + DEPTH * 6)) {
        const float* fg = args.in[19];
        const int tid = otid(wave_s), lane = tid & 63, wave = __builtin_amdgcn_readfirstlane(tid >> 6);
        const int xq = vcu & 7, rq = vcu >> 3;
        const int rs = xl ? xq * (T / 8) + rq * NWAVES + wave : bx * NWAVES + wave, rstride = xl ? (G / 8) * NWAVES : G * NWAVES, rend = xl ? (xq + 1) * (T / 8) : T;
        for (int row = rs; row < rend; row += 2 * rstride) {
            const bool two = row + rstride < rend; const int row2 = two ? row + rstride : row;
            v4u w[4], w2[4];
#pragma unroll
            for (int q = 0; q < 4; ++q) w[q] = *(const v4u*)(X + (size_t)row * D + q * 512 + lane * 8);
#pragma unroll
            for (int q = 0; q < 4; ++q) w2[q] = *(const v4u*)(X + (size_t)row2 * D + q * 512 + lane * 8);
#pragma unroll
            for (int h = 0; h < 2; ++h) { if (h == 1 && !two) continue; float* orow = args.out + (size_t)(h ? row2 : row) * D; float ss = 0.f;
                f32x4 v[8];
#pragma unroll
                for (int q = 0; q < 4; ++q) { const v4u ww = h ? w2[q] : w[q]; v[2 * q] = (f32x4){bflo(ww.x), bfhi(ww.x), bflo(ww.y), bfhi(ww.y)}; v[2 * q + 1] = (f32x4){bflo(ww.z), bfhi(ww.z), bflo(ww.w), bfhi(ww.w)}; }
#pragma unroll
                for (int q = 0; q < 8; ++q) ss += (v[q][0] * v[q][0] + v[q][1] * v[q][1]) + (v[q][2] * v[q][2] + v[q][3] * v[q][3]);
                const float rinv = 1.0f / sqrtf(wave_sum(ss, lane) * (1.0f / D) + EPS);
#pragma unroll
                for (int q = 0; q < 8; ++q) { const int c = (q >> 1) * 512 + lane * 8 + (q & 1) * 4; const f32x4 g4 = *(const f32x4*)(fg + c); *(f32x4*)(orow + c) = v[q] * rinv * g4; } }
        }
    }
    if (ECHO_MASK) { ECHO_TICK(2 + DEPTH * 6);
        if (bx == 0 && otid(wave_s) < 64) { const unsigned long long t_end = __builtin_amdgcn_s_memrealtime() + (unsigned long long)ECHO_MUL * echo_acc; while (__builtin_amdgcn_s_memrealtime() < t_end) __builtin_amdgcn_s_sleep(8); } }
#undef IN
#undef SEAM
}

extern "C" void kernel_launch(void* const* d_in, const int* in_sizes, int n_in, void* d_out, int out_size, void* d_ws, size_t ws_size, hipStream_t stream) {
    static int grid = 0;
    if (grid == 0) {
        if (n_in != 20 || out_size != T * D || ws_size < WS_END) { fprintf(stderr, "kernel_launch: built for 20 inputs, out of %d floats, >= %zu bytes of workspace; got n_in %d, out %d, ws %zu; nothing launched\n", T * D, (size_t)WS_END, n_in, out_size, ws_size); grid = -1; return; }
        int dev = 0, cus = 0, per_cu = 0;
        if (hipGetDevice(&dev) != hipSuccess || hipDeviceGetAttribute(&cus, hipDeviceAttributeMultiprocessorCount, dev) != hipSuccess) { fprintf(stderr, "kernel_launch: hipGetDevice / hipDeviceGetAttribute failed\n"); grid = -1; return; }
        if (hipFuncSetAttribute((const void*)enc_fwd, hipFuncAttributeMaxDynamicSharedMemorySize, LDS_BYTES) != hipSuccess) { fprintf(stderr, "kernel_launch: hipFuncSetAttribute failed\n"); grid = -1; return; }
        if (hipOccupancyMaxActiveBlocksPerMultiprocessor(&per_cu, (const void*)enc_fwd, NWAVES * 64, LDS_BYTES) != hipSuccess || per_cu < 1) { fprintf(stderr, "kernel_launch: occupancy query reports %d workgroups per CU\n", per_cu); }
        (void)hipGetLastError();
        grid = cus;
    }
    if (grid < 0) return;
    if (hipMemsetAsync((char*)d_ws + WS_CTL, 0, CTL_ZERO_BYTES, stream) != hipSuccess) { fprintf(stderr, "kernel_launch: hipMemsetAsync failed\n"); return; }
    Args a{};
    for (int i = 0; i < 20; ++i) a.in[i] = (const float*)d_in[i];
    a.out = (float*)d_out; a.ws = (unsigned char*)d_ws;
    constexpr int NPH = 3 + DEPTH * 6;
#if MK_PER_PHASE_LAUNCH
    for (int p = 0; p < NPH; ++p) { a.ph_lo = p; a.ph_hi = p + 1; hipLaunchKernelGGL(enc_fwd, dim3(grid), dim3(NWAVES * 64), LDS_BYTES, stream, a); }
#else
    a.ph_lo = 0; a.ph_hi = NPH;
    hipLaunchKernelGGL(enc_fwd, dim3(grid), dim3(NWAVES * 64), LDS_BYTES, stream, a);
#endif
    const hipError_t le = hipPeekAtLastError();
    if (le != hipSuccess) fprintf(stderr, "kernel_launch: launch failed: %s\n", hipGetErrorName(le));
}
```

```cpp
#include <hip/hip_runtime.h>
#include <cstdio>
#include <cstdint>

#ifndef SKIP_NORM
#define SKIP_NORM 0
#endif
#ifndef SKIP_POOL
#define SKIP_POOL 0
#endif
#ifndef SKIP_GATE
#define SKIP_GATE 0
#endif
#ifndef SKIP_P0
#define SKIP_P0 0
#endif
#ifndef ECHO_MASK
#define ECHO_MASK 0ull
#endif
#ifndef ECHO_MUL
#define ECHO_MUL 1
#endif
#ifndef MK_PER_PHASE_LAUNCH
#define MK_PER_PHASE_LAUNCH 0
#endif

__device__ __forceinline__ void xcd_wait2(unsigned* bar_, unsigned target, int wid, unsigned setoff = 0u);
namespace pg8 {
#define PG8_LAS __attribute__((address_space(3)))
typedef unsigned short bf16_t;
typedef short bf16x8 __attribute__((ext_vector_type(8)));
typedef float f32x4 __attribute__((ext_vector_type(4)));
typedef float f32x2 __attribute__((ext_vector_type(2)));
typedef unsigned u32x4 __attribute__((ext_vector_type(4)));
constexpr int BM = 256, BK = 64, HALF = 128, HTB = HALF * BK * 2  , STAGE_BYTES = 8 * HTB, NXCD = 8;

__host__ __device__ __forceinline__ int lds_byte(int r, int c) { const int st = (r >> 4) * 2 + (c >> 5), rr = r & 15, cc = c & 31, ob = rr * 64 + cc * 2; return st * 1024 + (ob ^ (((ob >> 9) & 1) << 5)); }
__host__ __device__ __forceinline__ void stage_rc(int b, int& R, int& C) { const int st = b / 1024, sb = b % 1024, swz = sb ^ (((sb >> 9) & 1) << 5); R = (st >> 1) * 16 + swz / 64; C = (st & 1) * 32 + (swz % 64) / 2; }
__host__ __device__ __forceinline__ int perm32(int rho) { const int n = rho >> 4, i = rho & 15; return 8 * (i >> 2) + 4 * n + (i & 3); }

struct Unit { int pm, pn; };
struct Gemm { const bf16_t* A; const bf16_t* Bt; int lda, ldb, M, N, K, a_kshift, a_kcols; };

struct StaticOrder {
    int nM, nN, nwg, G, c, WGM, rev;
    __host__ __device__ void init(int M, int N, int G_, int c_, int wgm = 4, int rev_ = 0) { nM = M / BM; nN = N / BM; nwg = nM * nN; G = G_; c = c_; WGM = wgm; rev = (rev_ && nwg % G_ == 0) ? nwg / G_ : 0; }
    __host__ __device__ bool next(int i, Unit& u) const {
        const long L = (long)(rev ? rev - 1 - i : i) * G + c; if (i < 0 || L < 0 || L >= nwg) return false;
        int wgid = (int)L; { const int q = nwg / NXCD, r = nwg % NXCD, xcd = wgid % NXCD, off = wgid / NXCD; wgid = (xcd < r ? xcd * (q + 1) : r * (q + 1) + (xcd - r) * q) + off; }
        const int nig = WGM * nN, gid = wgid / nig, fm = gid * WGM, gsz = (nM - fm) < WGM ? (nM - fm) : WGM;
        u.pm = fm + ((wgid % nig) % gsz); u.pn = (wgid % nig) / gsz; return true;
    }
    __device__ __forceinline__ void a_ready(const Unit&) const {}
    __device__ __forceinline__ void done(const Unit&) const {}
};

__device__ __forceinline__ int lane_asm() { int l; asm volatile("v_mbcnt_lo_u32_b32 %0, -1, 0\n\tv_mbcnt_hi_u32_b32 %0, -1, %0" : "=v"(l)); return l; }
__device__ __forceinline__ float shfl_xor_l(float v, int mask, int lane) { return __builtin_bit_cast(float, __builtin_amdgcn_ds_bpermute((lane ^ mask) << 2, __builtin_bit_cast(int, v))); }
__device__ __forceinline__ float row_sum16(float v) {
    v += __builtin_bit_cast(float, __builtin_amdgcn_update_dpp(0, __builtin_bit_cast(int, v), 0x111, 0xf, 0xf, true));
    v += __builtin_bit_cast(float, __builtin_amdgcn_update_dpp(0, __builtin_bit_cast(int, v), 0x112, 0xf, 0xf, true));
    v += __builtin_bit_cast(float, __builtin_amdgcn_update_dpp(0, __builtin_bit_cast(int, v), 0x114, 0xf, 0xf, true));
    v += __builtin_bit_cast(float, __builtin_amdgcn_update_dpp(0, __builtin_bit_cast(int, v), 0x118, 0xf, 0xf, true));
    return v;
}
__device__ __forceinline__ unsigned cvt_pk_bf16(float lo, float hi) { unsigned r; asm volatile("v_cvt_pk_bf16_f32 %0, %1, %2" : "=v"(r) : "v"(lo), "v"(hi)); return r; }
__device__ __forceinline__ f32x2 gelu_pk(f32x2 v) {
    f32x2 a; a.x = __builtin_fminf(__builtin_fabsf(v.x), 6.0f); a.y = __builtin_fminf(__builtin_fabsf(v.y), 6.0f);
    f32x2 p = a * 5.38297500e-06f + 4.88906356e-05f; p = p * a + 3.80035750e-05f; p = p * a + 3.27762633e-03f; p = p * a + 2.11410062e-02f; p = p * a + 4.98673470e-02f; p = p * a + 1.0f;
    p = p * p; p = p * p; p = p * p; p = p * p;
    const float m = p.x * p.y, rr = __builtin_amdgcn_rcpf(m + m);
    f32x2 q; q.x = rr * p.y; q.y = rr * p.x;
    const f32x2 z = {0.f, 0.f};
    return __builtin_elementwise_max(v, z) - a * q;
}
__device__ __forceinline__ f32x4 gelu4(f32x4 v) { const f32x2 a = gelu_pk((f32x2){v[0], v[1]}), b = gelu_pk((f32x2){v[2], v[3]}); return (f32x4){a.x, a.y, b.x, b.y}; }

__device__ __forceinline__ int batch_of_tile(int p) { return p < 32 ? 0 : (p < 64 ? 1 : 2); }
constexpr float SSQ_SCALE = 1024.0f, SSQ_INV = 1.0f / 1024.0f;
__device__ __forceinline__ void norm_prefetch(const float* rowsrc, const float* colsrc, PG8_LAS unsigned char* tab, int wid) {
    const int lane = lane_asm(), part = wid & 3;
    const float* src = ((wid >> 2) ? colsrc : rowsrc) + part * 64 + lane;
    __builtin_amdgcn_global_load_lds((const unsigned*)src, (PG8_LAS unsigned*)(tab + (wid >> 2) * 1024 + part * 256), 4, 0, 0);
}
template <bool SWAPPED>
__device__ __forceinline__ void norm_prepass(f32x4 (&acc)[2][2][4][2], const PG8_LAS unsigned char* tab, float inv_nd, float eps, int wr, int wc, int fr, int fq) {
    const PG8_LAS float* rt = (const PG8_LAS float*)tab + wr * 64 + fr; const PG8_LAS float* ct = (const PG8_LAS float*)(tab + 1024) + wc * 32 + 8 * fq;
    f32x4 cvv[2][2];
#pragma unroll
    for (int bj = 0; bj < 2; ++bj)
#pragma unroll
        for (int n = 0; n < 2; ++n) { f32x4 q = *(const PG8_LAS f32x4*)(ct + bj * HALF + 4 * n);
            if (SWAPPED) { const u32x4 qi = __builtin_bit_cast(u32x4, q); q = (f32x4){(float)qi[0], (float)qi[1], (float)qi[2], (float)qi[3]} * (SSQ_INV * inv_nd) + eps; q = (f32x4){__builtin_amdgcn_rsqf(q[0]), __builtin_amdgcn_rsqf(q[1]), __builtin_amdgcn_rsqf(q[2]), __builtin_amdgcn_rsqf(q[3])}; }
            cvv[bj][n] = q; }
#pragma unroll
    for (int ai = 0; ai < 2; ++ai)
#pragma unroll
        for (int m = 0; m < 4; ++m) { float r = rt[ai * HALF + m * 16]; if (!SWAPPED) r = __builtin_amdgcn_rsqf((float)__builtin_bit_cast(unsigned, r) * (SSQ_INV * inv_nd) + eps);
#pragma unroll
            for (int bj = 0; bj < 2; ++bj) { if (SWAPPED) { acc[ai][bj][m][0] = acc[ai][bj][m][0] * cvv[bj][0] + r; acc[ai][bj][m][1] = acc[ai][bj][m][1] * cvv[bj][1] + r; }
                                             else         { acc[ai][bj][m][0] = acc[ai][bj][m][0] * r + cvv[bj][0]; acc[ai][bj][m][1] = acc[ai][bj][m][1] * r + cvv[bj][1]; } } }
}
template <int ACT, bool NORMED> struct EpiBf16 {
    static constexpr bool PERM = true;
    static constexpr bool PREF = NORMED, RESTAGE = false;
    bf16_t* O; int ldc; const float* cs; const float* nss; const float* ncv; int ncvstride; PG8_LAS unsigned char* tabs;
    __device__ __forceinline__ void prefetch(const Unit& u, int wid, int buf) const { norm_prefetch(nss + u.pm * BM, ncv + (size_t)batch_of_tile(u.pm) * ncvstride + u.pn * BM, tabs + buf * 2048, wid); }
    __device__ __forceinline__ void operator()(f32x4 (&acc)[2][2][4][2], const Unit& u, int wr, int wc, int fr, int fq, int buf) const {
        if constexpr (NORMED) norm_prepass<false>(acc, tabs + buf * 2048, 1.0f / 2048.0f, 1e-6f, wr, wc, fr, fq);
        const int row0 = u.pm * BM + wr * 64 + fr, col0 = u.pn * BM + wc * 32 + 8 * fq;
        f32x4 sv[2][2];
#pragma unroll
        for (int bj = 0; bj < 2; ++bj)
#pragma unroll
            for (int n = 0; n < 2; ++n) sv[bj][n] = (ACT == 3) ? *(const f32x4*)(cs + col0 + bj * HALF + 4 * n) : (f32x4){1.f, 1.f, 1.f, 1.f};
#pragma unroll
        for (int ai = 0; ai < 2; ++ai)
#pragma unroll
            for (int m = 0; m < 4; ++m) { bf16_t* rowp = O + (size_t)(row0 + ai * HALF + m * 16) * ldc + col0;
#pragma unroll
                for (int bj = 0; bj < 2; ++bj) { f32x4 v0 = acc[ai][bj][m][0], v1 = acc[ai][bj][m][1];
                    if (ACT == 1) { v0 = gelu4(v0); v1 = gelu4(v1); }
                    if (ACT == 2) { v0 = __builtin_elementwise_max(v0, (f32x4){0.f, 0.f, 0.f, 0.f}); v1 = __builtin_elementwise_max(v1, (f32x4){0.f, 0.f, 0.f, 0.f}); v0 = v0 * v0; v1 = v1 * v1; }
                    if (ACT == 3) { v0 = v0 * sv[bj][0]; v1 = v1 * sv[bj][1]; }
                    u32x4 w; w.x = cvt_pk_bf16(v0[0], v0[1]); w.y = cvt_pk_bf16(v0[2], v0[3]); w.z = cvt_pk_bf16(v1[0], v1[1]); w.w = cvt_pk_bf16(v1[2], v1[3]);
                    *(u32x4*)(rowp + bj * HALF) = w; } }
    }
};
struct EpiVT {
    static constexpr bool PERM = true;
    static constexpr bool PREF = true, RESTAGE = false;
    bf16_t* VT; int ldt; float* ssp; int ssld; const float* nss; const float* ncv; int ncvstride; PG8_LAS unsigned char* tabs;
    __device__ __forceinline__ void prefetch(const Unit& u, int wid, int buf) const { norm_prefetch(ncv + (size_t)batch_of_tile(u.pn) * ncvstride + u.pm * BM, nss + u.pn * BM, tabs + buf * 2048, wid); }
    __device__ __forceinline__ void operator()(f32x4 (&acc)[2][2][4][2], const Unit& u, int wr, int wc, int fr, int fq, int buf) const {
        const int row0 = u.pm * BM + wr * 64 + fr, col0 = u.pn * BM + wc * 32 + 8 * fq;
        norm_prepass<true>(acc, tabs + buf * 2048, 1.0f / 2048.0f, 1e-6f, wr, wc, fr, fq);
        f32x4 ss[2][2];
#pragma unroll
        for (int bj = 0; bj < 2; ++bj)
#pragma unroll
            for (int n = 0; n < 2; ++n) ss[bj][n] = (f32x4){0.f, 0.f, 0.f, 0.f};
#pragma unroll
        for (int ai = 0; ai < 2; ++ai)
#pragma unroll
            for (int m = 0; m < 4; ++m) { bf16_t* rowp = VT + (size_t)(row0 + ai * HALF + m * 16) * ldt + col0;
#pragma unroll
                for (int bj = 0; bj < 2; ++bj) { const f32x4 v0 = gelu4(acc[ai][bj][m][0]), v1 = gelu4(acc[ai][bj][m][1]);
                    ss[bj][0] += v0 * v0; ss[bj][1] += v1 * v1;
                    u32x4 w; w.x = cvt_pk_bf16(v0[0], v0[1]); w.y = cvt_pk_bf16(v0[2], v0[3]); w.z = cvt_pk_bf16(v1[0], v1[1]); w.w = cvt_pk_bf16(v1[2], v1[3]);
                    *(u32x4*)(rowp + bj * HALF) = w; } }
#pragma unroll
        for (int bj = 0; bj < 2; ++bj)
#pragma unroll
            for (int n = 0; n < 2; ++n)
#pragma unroll
                for (int j = 0; j < 4; ++j) ss[bj][n][j] = row_sum16(ss[bj][n][j]);
        if (fr == 15) { float* p = ssp + (size_t)(u.pm * 2 + wr) * ssld + col0;
#pragma unroll
            for (int bj = 0; bj < 2; ++bj) { *(f32x4*)(p + bj * HALF) = ss[bj][0]; *(f32x4*)(p + bj * HALF + 4) = ss[bj][1]; } }
    }
};
struct EpiGate {
    static constexpr bool PERM = true;
    static constexpr bool PREF = true;
    static constexpr bool RESTAGE = true;
    static constexpr int SB0 = 131072, SB1 = 32768, SB2 = 98304, GTAB = 57344;
    bf16_t* Gt; int ldc; const bf16_t* VT; int ldt; const bf16_t* WsS; const float* gain; const float* b_s; PG8_LAS unsigned char* lb; const float* nss; const float* ncv; int ncvstride; PG8_LAS unsigned char* tabs; unsigned* lbar; unsigned ltarget;
    __device__ __forceinline__ void prefetch(const Unit& u, int wid, int buf) const { norm_prefetch(nss + u.pm * BM, ncv + (size_t)batch_of_tile(u.pm) * ncvstride + u.pn * BM, tabs + buf * 2048, wid); }
    __device__ __forceinline__ void late_wait(int wid) const { if (lbar) ::xcd_wait2(lbar, ltarget, wid); }
    __device__ __forceinline__ void operator()(f32x4 (&acc)[2][2][4][2], const Unit& u, int wr, int wc, int fr_, int fq_, int buf) const {
        int fr = fr_, fq = fq_; asm volatile("" : "+v"(fr), "+v"(fq));
        const int wid = wr * 4 + wc, h = u.pn / 3;
#define PG8_GSB(k) (((k) % 3) == 0 ? SB0 : (((k) % 3) == 1 ? SB1 : SB2))
#define PG8_GADDR() const int lane = fq * 16 + fr; \
        const unsigned voff = ((unsigned)(u.pn * BM + wr * HALF + wc * 32 + 8 * (fr >> 2) + (fr & 3)) * (unsigned)ldt + 8u * fq + (unsigned)(2 * u.pm) * 128u) * 2u; \
        const unsigned woff = ((unsigned)(((2 * u.pm) * 8 + h) * 8 + wid) * 2048u + lane * 8u) * 2u; const unsigned vrow4 = (unsigned)ldt * 8u
#define PG8_GISSUE(k) do { const int ai_ = (k) >> 2, kb_ = (k) & 3; PG8_LAS unsigned char* d_ = lb + PG8_GSB(k); \
            __builtin_amdgcn_global_load_lds((const unsigned*)((const char*)WsS + (woff + (unsigned)(ai_ * (8 * 8 * 2048) + kb_ * 512) * 2u)), (PG8_LAS unsigned*)(d_ + wid * 1024), 16, 0, 0); \
            __builtin_amdgcn_global_load_lds((const unsigned*)((const char*)VT + (voff + (unsigned)(ai_ * 128 + kb_ * 32) * 2u)), (PG8_LAS unsigned*)(d_ + 8192 + (wid * 2) * 1024), 16, 0, 0); \
            __builtin_amdgcn_global_load_lds((const unsigned*)((const char*)VT + (voff + vrow4 + (unsigned)(ai_ * 128 + kb_ * 32) * 2u)), (PG8_LAS unsigned*)(d_ + 8192 + (wid * 2) * 1024 + 1024), 16, 0, 0); } while (0)
        {   PG8_GADDR();
            PG8_GISSUE(0);
            if (wid < 4) __builtin_amdgcn_global_load_lds((const unsigned*)(gain + u.pn * BM + wid * 64 + lane), (PG8_LAS unsigned*)(lb + GTAB + wid * 256), 4, 0, 0);
            else if (wid < 6) __builtin_amdgcn_global_load_lds((const unsigned*)(b_s + h * 128 + (wid - 4) * 64 + lane), (PG8_LAS unsigned*)(lb + GTAB + 1024 + (wid - 4) * 256), 4, 0, 0);
            PG8_GISSUE(1); PG8_GISSUE(2); }
        __builtin_amdgcn_sched_barrier(0);
        norm_prepass<false>(acc, tabs + buf * 2048, 1.0f / 2048.0f, 1e-6f, wr, wc, fr, fq);
        __builtin_amdgcn_sched_barrier(0);
        asm volatile("" : "+v"(fr), "+v"(fq));
        PG8_GADDR();
        const int rwo = (4 * wr) * 1024 + lane * 16, rvo = 8192 + (wc * 2) * 1024 + lane * 16;
        f32x4 mx[2][4][2];
#define PG8_GGELU(ai, kb, q) do { constexpr int bjg_ = (kb) >> 1, mg_ = 2 * ((kb) & 1) + ((q) >> 1), ng_ = (q) & 1; acc[ai][bjg_][mg_][ng_] = gelu4(acc[ai][bjg_][mg_][ng_]); asm volatile("" : "+v"(acc[ai][bjg_][mg_][ng_])); } while (0)
#define PG8_GMMA(m, W) do { _Pragma("unroll") for (int bj = 0; bj < 2; ++bj) { mx[bj][m][0] = __builtin_amdgcn_mfma_f32_16x16x32_bf16(vtf[bj][0], W, mx[bj][m][0], 0, 0, 0); \
                                                                            mx[bj][m][1] = __builtin_amdgcn_mfma_f32_16x16x32_bf16(vtf[bj][1], W, mx[bj][m][1], 0, 0, 0); } } while (0)
#define PG8_GSTEP(k, WAITN) do { constexpr int ai = (k) >> 2, kb = (k) & 3; \
            asm volatile("s_waitcnt lgkmcnt(0)" ::: "memory"); asm volatile("s_waitcnt vmcnt(" #WAITN ")" ::: "memory"); __builtin_amdgcn_s_barrier(); asm volatile("" ::: "memory"); \
            if ((k) >= 1 && (k) + 2 <= 7) PG8_GISSUE(((k) >= 1 && (k) + 2 <= 7) ? (k) + 2 : 7); __builtin_amdgcn_sched_barrier(0); \
            if (kb == 0) { _Pragma("unroll") for (int bj = 0; bj < 2; ++bj) _Pragma("unroll") for (int m = 0; m < 4; ++m) { mx[bj][m][0] = (f32x4){0.f, 0.f, 0.f, 0.f}; mx[bj][m][1] = (f32x4){0.f, 0.f, 0.f, 0.f}; } } \
            { const PG8_LAS unsigned char* rw = lb + PG8_GSB(k) + rwo; const PG8_LAS unsigned char* rv = lb + PG8_GSB(k) + rvo; \
              bf16x8 vtf[2][2], wsfA, wsfB; \
              _Pragma("unroll") for (int bj = 0; bj < 2; ++bj) { vtf[bj][0] = *(const PG8_LAS bf16x8*)(rv + bj * 8192); vtf[bj][1] = *(const PG8_LAS bf16x8*)(rv + bj * 8192 + 1024); } \
              wsfA = *(const PG8_LAS bf16x8*)(rw); __builtin_amdgcn_sched_barrier(0); \
              PG8_GGELU(ai, kb, 0); __builtin_amdgcn_sched_barrier(0); \
              wsfB = *(const PG8_LAS bf16x8*)(rw + 1024); PG8_GMMA(0, wsfA); PG8_GGELU(ai, kb, 1); __builtin_amdgcn_sched_barrier(0); \
              wsfA = *(const PG8_LAS bf16x8*)(rw + 2048); PG8_GMMA(1, wsfB); PG8_GGELU(ai, kb, 2); __builtin_amdgcn_sched_barrier(0); \
              wsfB = *(const PG8_LAS bf16x8*)(rw + 3072); PG8_GMMA(2, wsfA); PG8_GGELU(ai, kb, 3); __builtin_amdgcn_sched_barrier(0); \
              PG8_GMMA(3, wsfB); } \
            __builtin_amdgcn_sched_barrier(0); \
            if (kb == 3) {     \
                f32x4 gv[2][2]; \
                _Pragma("unroll") for (int bj = 0; bj < 2; ++bj) { gv[bj][0] = *(const PG8_LAS f32x4*)(lb + GTAB + (wc * 32 + 8 * fq + bj * HALF) * 4); gv[bj][1] = *(const PG8_LAS f32x4*)(lb + GTAB + (wc * 32 + 8 * fq + bj * HALF) * 4 + 16); } \
                _Pragma("unroll") for (int m = 0; m < 4; ++m) { const int p = wr * 64 + m * 16 + fr; const float bsv = *(const PG8_LAS float*)(lb + GTAB + 1024 + p * 4); \
                    bf16_t* rowp = Gt + (size_t)(u.pm * BM + ai * HALF + p) * ldc + u.pn * BM + wc * 32 + 8 * fq; \
                    _Pragma("unroll") for (int bj = 0; bj < 2; ++bj) { const f32x4 v0 = acc[ai][bj][m][0] * (mx[bj][m][0] * gv[bj][0] + bsv), v1 = acc[ai][bj][m][1] * (mx[bj][m][1] * gv[bj][1] + bsv); \
                        u32x4 w; w.x = cvt_pk_bf16(v0[0], v0[1]); w.y = cvt_pk_bf16(v0[2], v0[3]); w.z = cvt_pk_bf16(v1[0], v1[1]); w.w = cvt_pk_bf16(v1[2], v1[3]); \
                        *(u32x4*)(rowp + bj * HALF) = w; } } \
                __builtin_amdgcn_sched_barrier(0); } } while (0)
        PG8_GSTEP(0, 6); PG8_GSTEP(1, 3); PG8_GSTEP(2, 3); PG8_GSTEP(3, 3); PG8_GSTEP(4, 11); PG8_GSTEP(5, 11); PG8_GSTEP(6, 3); PG8_GSTEP(7, 0);
        asm volatile("s_waitcnt lgkmcnt(0)" ::: "memory"); __builtin_amdgcn_s_barrier(); asm volatile("" ::: "memory");
#undef PG8_GSTEP
#undef PG8_GMMA
#undef PG8_GGELU
#undef PG8_GISSUE
#undef PG8_GADDR
#undef PG8_GSB
    }
};

struct EpiResid {
    static constexpr bool PERM = true, PREF = false, RESTAGE = false;
    bf16_t* X; int ldc; const float* gate; int gstride; bf16_t* XS; const float* gsn; int gsstride; float* ssn; const float* xin0; const float* xin1;
    __device__ __forceinline__ void prefetch(const Unit&, int, int) const {}
    __device__ __forceinline__ void operator()(f32x4 (&acc)[2][2][4][2], const Unit& u, int wr, int wc, int fr, int fq, int) const {
        const int row0 = u.pm * BM + wr * 64 + fr, col0 = u.pn * BM + wc * 32 + 8 * fq;
        const int b = batch_of_tile(u.pm);
        const float* gp = gate + (size_t)b * gstride + col0;
        int ln = fq * 16 + fr; asm volatile("" : "+v"(ln));
        f32x4 gv[2][2], sv[2][2];
#pragma unroll
        for (int bj = 0; bj < 2; ++bj) { gv[bj][0] = *(const f32x4*)(gp + bj * HALF); gv[bj][1] = *(const f32x4*)(gp + bj * HALF + 4); }
        if (XS) { const float* sp_ = gsn + (size_t)b * gsstride + col0;
#pragma unroll
            for (int bj = 0; bj < 2; ++bj) { sv[bj][0] = *(const f32x4*)(sp_ + bj * HALF); sv[bj][1] = *(const f32x4*)(sp_ + bj * HALF + 4); } }
#pragma unroll
        for (int ai = 0; ai < 2; ++ai)
#pragma unroll
            for (int mp = 0; mp < 2; ++mp) {
                f32x4 xx[2][2][2];
#pragma unroll
                for (int mm = 0; mm < 2; ++mm) { const int rrow = row0 + ai * HALF + (2 * mp + mm) * 16;
                    if (xin0) { const float* rowp = (u.pm < 64 ? xin0 + (size_t)rrow * ldc : xin1 + (size_t)(rrow - 16384) * ldc) + col0;
#pragma unroll
                        for (int bj = 0; bj < 2; ++bj) { xx[mm][bj][0] = *(const f32x4*)(rowp + bj * HALF); xx[mm][bj][1] = *(const f32x4*)(rowp + bj * HALF + 4); } }
                    else { const bf16_t* rowp = X + (size_t)rrow * ldc + col0;
#pragma unroll
                        for (int bj = 0; bj < 2; ++bj) { const u32x4 w = *(const u32x4*)(rowp + bj * HALF);
                            xx[mm][bj][0] = (f32x4){__builtin_bit_cast(float, w.x << 16), __builtin_bit_cast(float, w.x & 0xffff0000u), __builtin_bit_cast(float, w.y << 16), __builtin_bit_cast(float, w.y & 0xffff0000u)};
                            xx[mm][bj][1] = (f32x4){__builtin_bit_cast(float, w.z << 16), __builtin_bit_cast(float, w.z & 0xffff0000u), __builtin_bit_cast(float, w.w << 16), __builtin_bit_cast(float, w.w & 0xffff0000u)}; } } }
#pragma unroll
                for (int mm = 0; mm < 2; ++mm) { const int m = 2 * mp + mm, row = row0 + ai * HALF + m * 16; float ssq = 0.f;
#pragma unroll
                    for (int bj = 0; bj < 2; ++bj) { const f32x4 x0 = xx[mm][bj][0] + gv[bj][0] * acc[ai][bj][m][0], x1 = xx[mm][bj][1] + gv[bj][1] * acc[ai][bj][m][1];
                        u32x4 xw; xw.x = cvt_pk_bf16(x0[0], x0[1]); xw.y = cvt_pk_bf16(x0[2], x0[3]); xw.z = cvt_pk_bf16(x1[0], x1[1]); xw.w = cvt_pk_bf16(x1[2], x1[3]);
                        *(u32x4*)(X + (size_t)row * ldc + col0 + bj * HALF) = xw;
                        if (XS) { ssq += ((x0[0] * x0[0] + x0[1] * x0[1]) + (x0[2] * x0[2] + x0[3] * x0[3])) + ((x1[0] * x1[0] + x1[1] * x1[1]) + (x1[2] * x1[2] + x1[3] * x1[3]));
                            const f32x4 y0 = x0 * sv[bj][0], y1 = x1 * sv[bj][1];
                            u32x4 w; w.x = cvt_pk_bf16(y0[0], y0[1]); w.y = cvt_pk_bf16(y0[2], y0[3]); w.z = cvt_pk_bf16(y1[0], y1[1]); w.w = cvt_pk_bf16(y1[2], y1[3]);
                            *(u32x4*)(XS + (size_t)row * ldc + col0 + bj * HALF) = w; } }
                    if (XS) { ssq += shfl_xor_l(ssq, 16, ln); ssq += shfl_xor_l(ssq, 32, ln); if (fq == 0) atomicAdd((unsigned*)ssn + row, (unsigned)(ssq * SSQ_SCALE + 0.5f)); } }
                asm volatile("" ::: "memory"); }
    }
};

template <class Epi, class Sched, bool ALIGN_EPI>
__device__ __forceinline__ void gemm_phase(PG8_LAS unsigned char* lds, const Gemm g, const Sched& S, const Epi& E, const int wave_s) {
    int wid_ = wave_s; asm volatile("" : "+s"(wid_));
    const int wid = wid_, wr = wid >> 2, wc = wid & 3;
    const int K = g.K, nt = K / BK;
    unsigned voffA[2], voffB[2]; int aoff, boff;
#define PG8_LANE_SETUP() do { const int lane_ = lane_asm(), tid_ = wid * 64 + lane_, fr_ = lane_ & 15, fq_ = lane_ >> 4; \
        _Pragma("unroll") for (int i = 0; i < 2; ++i) { int R, C; stage_rc(tid_ * 16 + i * 8192, R, C); const int Rb = Epi::PERM ? ((R & ~31) + perm32(R & 31)) : R; \
            voffA[i] = (unsigned)(R * g.lda + C) * 2u; voffB[i] = (unsigned)(Rb * g.ldb + C) * 2u; } \
        aoff = lds_byte(wr * 64 + fr_, fq_ * 8); boff = lds_byte(wc * 32 + fr_, fq_ * 8); } while (0)
    PG8_LANE_SETUP();
    const size_t kstep = (size_t)(BK * 2);
    const size_t hstepA = (size_t)HALF * g.lda * 2, hstepB = (size_t)HALF * g.ldb * 2;
    const size_t tstepA = 2 * hstepA, tstepB = 2 * hstepB;
    const unsigned ldsw = (unsigned)wid * 1024u;
#define PG8_ABASE(u) ((const char*)g.A + (size_t)(u).pm * tstepA + (size_t)(((u).pn >> g.a_kshift) * g.a_kcols) * 2)
#define PG8_BBASE(u) ((const char*)g.Bt + (size_t)(u).pn * tstepB)
#define PG8_SA(b, h) (((b) * 2 + (h)) * HTB)
#define PG8_SB(b, h) ((4 + (b) * 2 + (h)) * HTB)
#define PG8_STAGE(bufoff, gbase, voff) do { _Pragma("unroll") for (int _i = 0; _i < 2; ++_i) \
        __builtin_amdgcn_global_load_lds((const unsigned*)((const char*)(gbase) + (voff)[_i]), (PG8_LAS unsigned*)(lds + (bufoff) + ldsw + _i * 8192), 16, 0, 0); } while (0)
#define PG8_LDA(dst, b, h) do { _Pragma("unroll") for (int m = 0; m < 4; ++m) _Pragma("unroll") for (int k = 0; k < 2; ++k) dst[m][k] = *(const PG8_LAS bf16x8*)(lds + PG8_SA(b, h) + aoff + m * 2048 + k * 1024); } while (0)
#define PG8_LDB(dst, b, h) do { _Pragma("unroll") for (int n = 0; n < 2; ++n) _Pragma("unroll") for (int k = 0; k < 2; ++k) dst[n][k] = *(const PG8_LAS bf16x8*)(lds + PG8_SB(b, h) + boff + n * 2048 + k * 1024); } while (0)
#define PG8_MMA(ai, bj, At, Bt) do { __builtin_amdgcn_s_setprio(1); _Pragma("unroll") for (int m = 0; m < 4; ++m) _Pragma("unroll") for (int n = 0; n < 2; ++n) _Pragma("unroll") for (int k = 0; k < 2; ++k) \
        acc[ai][bj][m][n] = __builtin_amdgcn_mfma_f32_16x16x32_bf16(Bt[n][k], At[m][k], acc[ai][bj][m][n], 0, 0, 0); __builtin_amdgcn_s_setprio(0); } while (0)
#define PG8_MMA_HEAD(ai, At, B0_) do { __builtin_amdgcn_s_setprio(1); _Pragma("unroll") for (int k = 0; k < 2; ++k) \
        acc[ai][0][0][0] = __builtin_amdgcn_mfma_f32_16x16x32_bf16(B0_[0][k], At[0][k], acc[ai][0][0][0], 0, 0, 0); } while (0)
#define PG8_MMA_TAIL(ai, At, B0_, B1_) do { _Pragma("unroll") for (int k = 0; k < 2; ++k) acc[ai][0][0][1] = __builtin_amdgcn_mfma_f32_16x16x32_bf16(B0_[1][k], At[0][k], acc[ai][0][0][1], 0, 0, 0); \
        _Pragma("unroll") for (int m = 1; m < 4; ++m) _Pragma("unroll") for (int n = 0; n < 2; ++n) _Pragma("unroll") for (int k = 0; k < 2; ++k) \
        acc[ai][0][m][n] = __builtin_amdgcn_mfma_f32_16x16x32_bf16(B0_[n][k], At[m][k], acc[ai][0][m][n], 0, 0, 0); \
        _Pragma("unroll") for (int m = 0; m < 4; ++m) _Pragma("unroll") for (int n = 0; n < 2; ++n) _Pragma("unroll") for (int k = 0; k < 2; ++k) \
        acc[ai][1][m][n] = __builtin_amdgcn_mfma_f32_16x16x32_bf16(B1_[n][k], At[m][k], acc[ai][1][m][n], 0, 0, 0); __builtin_amdgcn_s_setprio(0); } while (0)
#define PG8_WAIT_V(n) asm volatile("s_waitcnt vmcnt(" #n ")" ::: "memory")
#define PG8_WAIT_L(n) asm volatile("s_waitcnt lgkmcnt(" #n ")" ::: "memory")
#define PG8_BAR __builtin_amdgcn_s_barrier()
#define PG8_SCHED __builtin_amdgcn_sched_barrier(0)
    Unit cur, nxt; int ui = 0;
    if (!S.next(0, cur)) return;
    f32x4 acc[2][2][4][2];
#pragma unroll
    for (int a = 0; a < 2; ++a)
#pragma unroll
        for (int b = 0; b < 2; ++b)
#pragma unroll
            for (int m = 0; m < 4; ++m)
#pragma unroll
                for (int n = 0; n < 2; ++n) acc[a][b][m][n] = (f32x4){0.f, 0.f, 0.f, 0.f};
    bf16x8 At[4][2], B0[2][2], B1[2][2];
    const char* cA = PG8_ABASE(cur); const char* cB = PG8_BBASE(cur);
    S.a_ready(cur);
    if constexpr (Epi::PREF) E.prefetch(cur, wid, 0);
    PG8_STAGE(PG8_SB(0, 0), cB, voffB); PG8_STAGE(PG8_SB(0, 1), cB + hstepB, voffB); PG8_STAGE(PG8_SA(0, 0), cA, voffA); PG8_STAGE(PG8_SA(0, 1), cA + hstepA, voffA);
    if (wr == 1) PG8_BAR;
    PG8_WAIT_V(2); PG8_BAR;
    PG8_STAGE(PG8_SB(1, 0), cB + kstep, voffB); PG8_STAGE(PG8_SA(1, 0), cA + kstep, voffA); PG8_STAGE(PG8_SB(1, 1), cB + hstepB + kstep, voffB);
    PG8_WAIT_V(6); PG8_BAR;
    for (;;) {
        const bool has_next = S.next(ui + 1, nxt);
        const char* nA = has_next ? PG8_ABASE(nxt) : cA; const char* nB = has_next ? PG8_BBASE(nxt) : cB;
        for (int t = 0; t < nt; t += 2) {
            const bool last = (t == nt - 2);
            const char* a1 = cA + (size_t)(t + 1) * kstep;
            const char* a2 = last ? nA : cA + (size_t)(t + 2) * kstep; const char* b2 = last ? nB : cB + (size_t)(t + 2) * kstep;
            const char* a3 = a2 + kstep; const char* b3 = b2 + kstep;
            if (last && has_next) S.a_ready(nxt);
            PG8_LDB(B0, 0, 0); PG8_LDB(B1, 0, 1); PG8_SCHED; PG8_LDA(At, 0, 0); PG8_STAGE(PG8_SA(1, 1), a1 + hstepA, voffA);
            PG8_WAIT_V(8); PG8_WAIT_L(0); PG8_MMA_HEAD(0, At, B0); PG8_SCHED; PG8_BAR; PG8_SCHED; PG8_MMA_TAIL(0, At, B0, B1); PG8_BAR; PG8_SCHED;
            PG8_LDA(At, 0, 1); PG8_STAGE(PG8_SB(0, 0), b2, voffB); PG8_STAGE(PG8_SB(0, 1), b2 + hstepB, voffB); PG8_STAGE(PG8_SA(0, 0), a2, voffA);
            PG8_WAIT_V(8); PG8_WAIT_L(0); PG8_MMA_HEAD(1, At, B0); PG8_SCHED; PG8_BAR; PG8_SCHED; PG8_MMA_TAIL(1, At, B0, B1); PG8_BAR; PG8_SCHED;
            PG8_LDB(B0, 1, 0); PG8_LDB(B1, 1, 1); PG8_SCHED; PG8_LDA(At, 1, 0); PG8_STAGE(PG8_SA(0, 1), a2 + hstepA, voffA);
            PG8_WAIT_V(8); PG8_WAIT_L(0); PG8_MMA_HEAD(0, At, B0); PG8_SCHED; PG8_BAR; PG8_SCHED; PG8_MMA_TAIL(0, At, B0, B1); PG8_BAR; PG8_SCHED;
            PG8_LDA(At, 1, 1); if (!(Epi::RESTAGE && last)) { PG8_STAGE(PG8_SB(1, 0), b3, voffB); PG8_STAGE(PG8_SB(1, 1), b3 + hstepB, voffB); PG8_STAGE(PG8_SA(1, 0), a3, voffA); }
            PG8_WAIT_V(8); PG8_WAIT_L(0); PG8_MMA_HEAD(1, At, B0); PG8_SCHED; PG8_BAR; PG8_SCHED; PG8_MMA_TAIL(1, At, B0, B1); PG8_BAR; PG8_SCHED;
        }
        if constexpr (ALIGN_EPI) { if (wr == 0) PG8_BAR; }
        if constexpr (Epi::PREF && Epi::RESTAGE) { if (has_next) E.prefetch(nxt, wid, (ui + 1) & 1); }
        if constexpr (Epi::RESTAGE) { if (ui == 0) E.late_wait(wid); }
        { const int lane_e = lane_asm(); E(acc, cur, wr, wc, lane_e & 15, lane_e >> 4, ui & 1); } S.done(cur);
        if constexpr (Epi::PREF && !Epi::RESTAGE) { if (has_next) E.prefetch(nxt, wid, (ui + 1) & 1); }
        if (!has_next) break;
#pragma unroll
        for (int a = 0; a < 2; ++a)
#pragma unroll
            for (int b = 0; b < 2; ++b)
#pragma unroll
                for (int m = 0; m < 4; ++m)
#pragma unroll
                    for (int n = 0; n < 2; ++n) acc[a][b][m][n] = (f32x4){0.f, 0.f, 0.f, 0.f};
        cur = nxt; cA = nA; cB = nB; ++ui;
        PG8_LANE_SETUP();
        if constexpr (Epi::RESTAGE) { PG8_STAGE(PG8_SB(1, 0), cB + kstep, voffB); PG8_STAGE(PG8_SB(1, 1), cB + hstepB + kstep, voffB); PG8_STAGE(PG8_SA(1, 0), cA + kstep, voffA); }
        if constexpr (ALIGN_EPI) { if (wr == 1) PG8_BAR; }
    }
    PG8_WAIT_V(0);
    if constexpr (!ALIGN_EPI) { if (wr == 0) PG8_BAR; }
    PG8_BAR;
#undef PG8_LANE_SETUP
#undef PG8_ABASE
#undef PG8_BBASE
#undef PG8_SA
#undef PG8_SB
#undef PG8_STAGE
#undef PG8_LDA
#undef PG8_LDB
#undef PG8_MMA
#undef PG8_MMA_HEAD
#undef PG8_MMA_TAIL
#undef PG8_WAIT_V
#undef PG8_WAIT_L
#undef PG8_BAR
#undef PG8_SCHED
}
}

constexpr int NWAVES = 8;
constexpr int D = 2048, T = 32768, DEPTH = 4, NBATCH = 3;
constexpr int FF = 8192, SFF = 12288, SHALF = 6144, NHEADS = 8, HDIM = 768, CHUNK = 128, NMOD = 6, PGRP = 512;
constexpr int VTLD = T + 64;
constexpr int NSSP = 48;
constexpr float EPS = 1e-6f;

constexpr size_t MiB = 1u << 20;
constexpr size_t WS_CTL = 0, CTL_ZERO_BYTES = 57344;
constexpr size_t WS_MODV = 1 * MiB;
constexpr size_t WS_SSP = 2 * MiB;
constexpr size_t WS_WPIN = 8 * MiB;
constexpr size_t WS_WPGRP = 24 * MiB;
constexpr size_t WS_WPOUT = 28 * MiB;
constexpr size_t WS_WSIN = 44 * MiB;
constexpr size_t WS_WSOUT = 140 * MiB;
constexpr size_t WS_W1 = 188 * MiB;
constexpr size_t WS_W2 = 316 * MiB;
constexpr size_t WS_H = 444 * MiB;
constexpr size_t WS_BIG = 572 * MiB;
constexpr size_t WS_WSS = 1341 * MiB;
constexpr size_t WS_SSX = 1405 * MiB;
constexpr size_t SSX_BYTES = (size_t)9 * 32768 * 4;
constexpr size_t WS_GS = 64 * 1024;
constexpr size_t WS_CVM = 1407 * MiB;
constexpr size_t WS_CV1 = 1 * MiB + 640 * 1024;
constexpr size_t WS_XB = 1408 * MiB;
constexpr size_t WS_END = 1536 * MiB;
constexpr int CW_BAR = 4096;

#define LAS __attribute__((address_space(3)))
typedef unsigned short bf16;
typedef unsigned v4u __attribute__((ext_vector_type(4)));
typedef unsigned v2u __attribute__((ext_vector_type(2)));
typedef float f32x4 __attribute__((ext_vector_type(4)));
typedef short bf16x8 __attribute__((ext_vector_type(8)));
#define LDS_WAIT() asm volatile("s_waitcnt lgkmcnt(0)" ::: "memory")
__device__ __forceinline__ unsigned f2bf(float f) { unsigned u = __builtin_bit_cast(unsigned, f); return (u + 0x7fffu + ((u >> 16) & 1u)) >> 16; }
__device__ __forceinline__ unsigned pk2(float lo, float hi) { return f2bf(lo) | (f2bf(hi) << 16); }
__device__ __forceinline__ float bflo(unsigned w) { return __builtin_bit_cast(float, w << 16); }
__device__ __forceinline__ float bfhi(unsigned w) { return __builtin_bit_cast(float, w & 0xffff0000u); }

#define XB_TMO      128
#define XB_XCNT(j)  (256  + 64 * (j))
#define XB_XSUB(j)  (1280 + 64 * (j))
#define XB_XGEN(j)  (2304 + 64 * (j))
#define XB_TOP      3328
#define XB_TOPGEN   3392
#define XCD_BAR_WORDS 3456
#define XB_XSUB2(j) (3456 + 64 * (j))
#define XB_TOP2     4480
#define XB_TOPGEN2  4544
#define XB_XGEN2(j) (4608 + 64 * (j))
#define XB_LSUB(j)  (7808 + 64 * (j))
#define XB_LGEN(j)  (8832 + 64 * (j))
#define XB_SET(s)   ((s) * 2176u)
#define XB_SPIN_CAP (1u << 18)

__device__ __forceinline__ unsigned xb_ld(unsigned* p)              { return __hip_atomic_load(p, __ATOMIC_RELAXED, __HIP_MEMORY_SCOPE_AGENT); }
__device__ __forceinline__ unsigned xb_add(unsigned* p, unsigned v) { return __hip_atomic_fetch_add(p, v, __ATOMIC_RELAXED, __HIP_MEMORY_SCOPE_AGENT); }
__device__ __forceinline__ unsigned xb_xcc_id() { return (unsigned)__builtin_amdgcn_s_getreg((3 << 11) | 20) & 0xFu; }
#define XB_SPIN(cond, bar) do { unsigned _sp = 0; while (cond) { __builtin_amdgcn_s_sleep(1); \
    if ((++_sp & 255u) == 0u) { if (xb_ld(&(bar)[XB_TMO])) break; if (_sp > XB_SPIN_CAP) { atomicAdd(&(bar)[XB_TMO], 1u); break; } } } } while (0)

struct XcdBarrier {
    unsigned* bar; unsigned x;
    volatile LAS unsigned* st;
};
__device__ __forceinline__ XcdBarrier xcd_barrier_post(unsigned* bar, volatile LAS unsigned* st) {
    XcdBarrier b; b.bar = bar; b.x = xb_xcc_id(); b.st = st;
    if (threadIdx.x == 0) { const unsigned rank = xb_add(&bar[XB_XCNT(b.x)], 1u); st[2] = rank; st[3] = b.x; }
    return b;
}
__device__ __forceinline__ void xcd_barrier_complete(unsigned* bar, unsigned x, unsigned& nloc, unsigned& nx) {
    const unsigned G = gridDim.x * gridDim.y * gridDim.z;
    unsigned sum, cnt, mine, sp = 0u;
    for (;;) {
        sum = 0u; cnt = 0u; mine = 0u;
#pragma unroll
        for (unsigned j = 0; j < 16; ++j) { const unsigned c = xb_ld(&bar[XB_XCNT(j)]); sum += c; cnt += (c > 0u) ? 1u : 0u; mine = (j == x) ? c : mine; }
        if (sum == G) break;
        __builtin_amdgcn_s_sleep(1);
        if ((++sp & 255u) == 0u) { if (xb_ld(&bar[XB_TMO])) break; if (sp > XB_SPIN_CAP) { atomicAdd(&bar[XB_TMO], 1u); break; } }
    }
    nloc = mine > 0u ? mine : 1u; nx = cnt > 0u ? cnt : 1u;
}
__device__ __forceinline__ void xcd_barrier(const XcdBarrier& b, const int wave_s) {
    asm volatile("s_waitcnt vmcnt(0)" ::: "memory");
    __syncthreads();
    if (wave_s == 0 && pg8::lane_asm() == 0) {
        unsigned* bar = b.bar; asm volatile("" : "+s"(bar));
        __builtin_amdgcn_s_waitcnt(0);
        const unsigned bx_ = xb_xcc_id();
        unsigned nloc = b.st[0], nx = b.st[1];
        if (nloc == 0u) { xcd_barrier_complete(bar, bx_, nloc, nx); b.st[0] = nloc; b.st[1] = nx; }
        const unsigned old = xb_add(&bar[XB_XSUB(bx_)], 1u);
        const unsigned gen = old / nloc;
        if (old + 1u == (gen + 1u) * nloc) {
            __builtin_amdgcn_fence(__ATOMIC_RELEASE, "agent");
            asm volatile("s_waitcnt vmcnt(0)" ::: "memory");
            const unsigned og = xb_add(&bar[XB_TOP], 1u);
            const unsigned tg = og / nx;
            if (og + 1u == (tg + 1u) * nx) xb_add(&bar[XB_TOPGEN], 1u);
            else XB_SPIN(xb_ld(&bar[XB_TOPGEN]) == tg, bar);
            __builtin_amdgcn_fence(__ATOMIC_ACQUIRE, "agent");
            xb_add(&bar[XB_XGEN(bx_)], 1u);
            asm volatile("s_waitcnt vmcnt(0)" ::: "memory");
        } else {
            XB_SPIN(xb_ld(&bar[XB_XGEN(bx_)]) == gen, bar);
            __builtin_amdgcn_fence(__ATOMIC_ACQUIRE, "agent");
            asm volatile("s_waitcnt vmcnt(0)" ::: "memory");
        }
    }
    __syncthreads();
}
__device__ __forceinline__ void xcd_local_barrier(const XcdBarrier& b, const int wave_s) {
    asm volatile("s_waitcnt vmcnt(0)" ::: "memory");
    __syncthreads();
    if (wave_s == 0 && pg8::lane_asm() == 0) {
        unsigned* bar = b.bar; asm volatile("" : "+s"(bar));
        __builtin_amdgcn_s_waitcnt(0);
        const unsigned bx_ = xb_xcc_id();
        const unsigned nloc = b.st[0];
        const unsigned old = xb_add(&bar[XB_LSUB(bx_)], 1u);
        const unsigned gen = old / nloc;
        if (old + 1u == (gen + 1u) * nloc) xb_add(&bar[XB_LGEN(bx_)], 1u);
        else XB_SPIN(xb_ld(&bar[XB_LGEN(bx_)]) == gen, bar);
        __builtin_amdgcn_fence(__ATOMIC_ACQUIRE, "agent");
        asm volatile("s_waitcnt vmcnt(0)" ::: "memory");
    }
    __syncthreads();
}
__device__ __forceinline__ void xcd_arrive2(const XcdBarrier& b, const int wave_s, const unsigned setoff = 0u) {
    asm volatile("s_waitcnt vmcnt(0)" ::: "memory");
    __syncthreads();
    if (wave_s == 0 && pg8::lane_asm() == 0) {
        unsigned* bar = b.bar; asm volatile("" : "+s"(bar));
        __builtin_amdgcn_s_waitcnt(0);
        const unsigned bx_ = xb_xcc_id();
        unsigned nloc = b.st[0], nx = b.st[1];
        if (nloc == 0u) { xcd_barrier_complete(bar, bx_, nloc, nx); b.st[0] = nloc; b.st[1] = nx; }
        const unsigned old = xb_add(&bar[setoff + XB_XSUB2(bx_)], 1u);
        const unsigned gen = old / nloc;
        if (old + 1u == (gen + 1u) * nloc) {
            __builtin_amdgcn_fence(__ATOMIC_RELEASE, "agent");
            asm volatile("s_waitcnt vmcnt(0)" ::: "memory");
            const unsigned og = xb_add(&bar[setoff + XB_TOP2], 1u);
            const unsigned tg = og / nx;
            if (og + 1u == (tg + 1u) * nx) {
                xb_add(&bar[setoff + XB_TOPGEN2], 1u);
#pragma unroll
                for (unsigned jx = 0; jx < 16; ++jx) xb_add(&bar[setoff + XB_XGEN2(jx)], 1u);
            }
            asm volatile("s_waitcnt vmcnt(0)" ::: "memory");
        }
    }
}
__device__ __forceinline__ void xcd_wait2(unsigned* bar_, unsigned target, int wid, unsigned setoff) {
    if (wid == 0 && pg8::lane_asm() == 0) {
        unsigned* bar = bar_; asm volatile("" : "+s"(bar));
        const unsigned bx_ = xb_xcc_id();
        XB_SPIN(xb_ld(&bar[setoff + XB_XGEN2(bx_)]) < target, bar);
        __builtin_amdgcn_fence(__ATOMIC_ACQUIRE, "agent");
        asm volatile("s_waitcnt vmcnt(0)" ::: "memory");
    }
    asm volatile("" ::: "memory"); __builtin_amdgcn_s_barrier(); asm volatile("" ::: "memory");
}

constexpr int RING_OFF = 0, RING_BYTES = 131072;
constexpr int SPARE_OFF = RING_BYTES, SPARE_BYTES = 24576;
constexpr int TAB_OFF = SPARE_OFF + SPARE_BYTES + 128;
constexpr int MISC_OFF = SPARE_OFF + SPARE_BYTES;
constexpr int LDS_BYTES = 163840;

__device__ __forceinline__ int opaque_s(int v) { asm volatile("" : "+s"(v)); return v; }
__device__ __forceinline__ int otid(int wave_s) { return wave_s * 64 + pg8::lane_asm(); }
__device__ __forceinline__ float wave_sum(float v, int lane) {
#pragma unroll
    for (int o = 1; o < 64; o <<= 1) v += pg8::shfl_xor_l(v, o, lane);
    return v;
}

__device__ __forceinline__ void p0_transpose_item(const float* W, int K, int N, bf16* WT, LAS float* scr, int item, int lane) {
    const int nblk = N / 32, kb = item / nblk, nb = item % nblk, k0 = 64 * kb, n0 = 32 * nb;
#pragma unroll 8
    for (int i = 0; i < 32; ++i) { const int kk = 2 * i + (lane >> 5); scr[kk * 33 + (lane & 31)] = __builtin_nontemporal_load(W + (size_t)(k0 + kk) * N + n0 + (lane & 31)); }
    LDS_WAIT(); asm volatile("" ::: "memory");
    const int c = lane & 7;
#pragma unroll
    for (int j = 0; j < 4; ++j) { const int n = (lane >> 3) + 8 * j; const LAS float* s = scr + (8 * c) * 33 + n;
        v4u o; o.x = pk2(s[0 * 33], s[1 * 33]); o.y = pk2(s[2 * 33], s[3 * 33]); o.z = pk2(s[4 * 33], s[5 * 33]); o.w = pk2(s[6 * 33], s[7 * 33]);
        *(v4u*)(WT + (size_t)(n0 + n) * K + k0 + 8 * c) = o; }
    LDS_WAIT(); asm volatile("" ::: "memory");
}
__device__ __forceinline__ void p0_scale_item(const float* Wg, const float* scale, bf16* WG, int item, int lane) {
    const int mat = item >> 7;
#pragma unroll
    for (int q = 0; q < 8; ++q) { const size_t idx = (size_t)item * 2048 + q * 256 + lane * 4; const int e = (int)(idx & 511);
        const f32x4 w = *(const f32x4*)(Wg + idx) * *(const f32x4*)(scale + mat * 512 + e);
        v2u o; o.x = pk2(w[0], w[1]); o.y = pk2(w[2], w[3]); *(v2u*)(WG + idx) = o; }
}
__device__ __forceinline__ bool p0_stack(int& it, const float* W, int L, int K, int N, bf16* WT, LAS float* scr, int lane) {
    const int per = (K / 64) * (N / 32), tot = L * per;
    if (it >= tot) { it -= tot; return false; }
    const int l = it / per, r = it % per;
    p0_transpose_item(W + (size_t)l * K * N, K, N, WT + (size_t)l * K * N, scr, r, lane);
    return true;
}

__device__ __forceinline__ void gemv3_item(const float* W, size_t ldw, int e0, const LAS float* vec, const float* bias, float* out, size_t ostride, LAS float* red, int tid, int lane, int wave) {
    const int r4 = lane >> 4, c4 = (lane & 15) * 4;
    const float* wp = W + (size_t)(wave * 256 + r4) * ldw + e0 + c4;
    f32x4 a0 = {0.f, 0.f, 0.f, 0.f}, a1 = a0, a2 = a0;
#pragma unroll 16
    for (int it = 0; it < 64; ++it) { const f32x4 w = __builtin_nontemporal_load((const f32x4*)(wp + (size_t)it * 4 * ldw)); const int d = wave * 256 + it * 4 + r4;
        a0 += w * vec[d]; a1 += w * vec[2048 + d]; a2 += w * vec[4096 + d]; }
#pragma unroll
    for (int j = 0; j < 4; ++j) { a0[j] += __shfl_xor(a0[j], 16); a0[j] += __shfl_xor(a0[j], 32); a1[j] += __shfl_xor(a1[j], 16); a1[j] += __shfl_xor(a1[j], 32); a2[j] += __shfl_xor(a2[j], 16); a2[j] += __shfl_xor(a2[j], 32); }
    if (lane < 16) { *(LAS f32x4*)(red + (wave * 3 + 0) * 64 + c4) = a0; *(LAS f32x4*)(red + (wave * 3 + 1) * 64 + c4) = a1; *(LAS f32x4*)(red + (wave * 3 + 2) * 64 + c4) = a2; }
    __syncthreads();
    if (tid < 192) { const int b = tid / 64, c = tid % 64; float sacc = bias ? bias[e0 + c] : 0.f;
#pragma unroll
        for (int w = 0; w < 8; ++w) sacc += red[(w * 3 + b) * 64 + c];
        out[(size_t)b * ostride + e0 + c] = sacc; }
    __syncthreads();
}

struct Args {
    const float* in[20]; float* out; unsigned char* ws; int ph_lo, ph_hi;
};

__global__ void __launch_bounds__(NWAVES * 64, 2) enc_fwd(Args args) {
    extern __shared__ __attribute__((aligned(16))) unsigned char lds_raw[];
    LAS unsigned char* lds = (LAS unsigned char*)lds_raw;
    volatile LAS unsigned* MISC = (volatile LAS unsigned*)(lds + MISC_OFF);
    const int tid = threadIdx.x, lane = tid & 63, wave = __builtin_amdgcn_readfirstlane(tid >> 6), wave_s = wave;
    const int G = gridDim.x, bx = blockIdx.x;
    unsigned char* ws = args.ws;
    unsigned* ctl = (unsigned*)(ws + WS_CTL);
    bf16* X = (bf16*)(ws + WS_XB);
    float* MODV = (float*)(ws + WS_MODV);
    float* SSP = (float*)(ws + WS_SSP);
    bf16* Hb = (bf16*)(ws + WS_H);
    bf16* BIG = (bf16*)(ws + WS_BIG);

    for (int u = tid; u < 32; u += NWAVES * 64) ((LAS unsigned*)(lds + MISC_OFF))[u] = 0u;
    __syncthreads();
#if MK_PER_PHASE_LAUNCH
#define GRID_BAR() do { } while (0)
#else
    XcdBarrier bar = xcd_barrier_post(ctl + CW_BAR, MISC + 8);
#define GRID_BAR() xcd_barrier(bar, wave_s)
#endif
#if MK_PER_PHASE_LAUNCH
    const int lo = args.ph_lo;
#define IN(k) (lo == (k))
#else
#define IN(k) true
#endif
    unsigned long long echo_last = ECHO_MASK ? __builtin_amdgcn_s_memrealtime() : 0ull, echo_acc = 0ull;
#define ECHO_TICK(k) do { if (ECHO_MASK) { const unsigned long long now_ = __builtin_amdgcn_s_memrealtime(); if ((ECHO_MASK >> (k)) & 1ull) echo_acc += now_ - echo_last; echo_last = now_; } } while (0)
#define SEAM(k) do { if (IN(k) && IN((k) + 1)) GRID_BAR(); ECHO_TICK(k); } while (0)

    float* SSX = (float*)(ws + WS_SSX); float* GS = (float*)(ws + WS_GS); float* CVM = (float*)(ws + WS_CVM); float* CV1 = (float*)(ws + WS_CV1);
    if (IN(0) && !SKIP_P0) {
        { const f32x4 z4 = {0.f, 0.f, 0.f, 0.f}; for (int u = bx * (NWAVES * 64) + tid; u < 8 * T / 4; u += G * (NWAVES * 64)) *(f32x4*)(SSX + T + (size_t)u * 4) = z4; }
        LAS float* cact = (LAS float*)(lds + RING_OFF);
        LAS float* red = (LAS float*)(lds + RING_OFF + 32768);
        for (int u = tid; u < NBATCH * D; u += NWAVES * 64) { const int b = u / D, d = u % D; const float c = (b < 2) ? args.in[2][b * D + d] : args.in[3][d]; cact[u] = c / (1.0f + __expf(-c)); }
        __syncthreads();
        for (int item = bx; item < DEPTH * (NMOD * D / 64); item += G) {
            const int i = item / (NMOD * D / 64), e0 = (item % (NMOD * D / 64)) * 64;
            gemv3_item(args.in[6] + (size_t)i * D * (NMOD * D), NMOD * D, e0, cact, args.in[7] + (size_t)i * (NMOD * D), MODV + (size_t)i * NBATCH * (NMOD * D), NMOD * D, red, tid, lane, wave);
        }
#if !MK_PER_PHASE_LAUNCH
        xcd_arrive2(bar, wave_s, XB_SET(1));
#endif
        LAS float* scr = (LAS float*)(lds + RING_OFF + wave * 16384);
        const int gw = bx * NWAVES + wave, NGW = G * NWAVES;
        constexpr int NITEMS = 2 * (D / 64) * (D / 32) * 2 + 8 * (PGRP / 64) * (PGRP / 32) + 2 * (D / 64) * (SFF / 32) + 2 * (SHALF / 64) * (D / 32) + 4 * (D / 64) * (FF / 32) + 4 * (FF / 64) * (D / 32);
        for (int it0 = gw; it0 < NITEMS; it0 += NGW) {
            int it = it0;
            if (p0_stack(it, args.in[8], 2, D, D, (bf16*)(ws + WS_WPIN), scr, lane)) continue;
            if (it < 8 * (PGRP / 64) * (PGRP / 32)) { p0_scale_item(args.in[9], args.in[10], (bf16*)(ws + WS_WPGRP), it, lane); continue; }
            it -= 8 * (PGRP / 64) * (PGRP / 32);
            if (p0_stack(it, args.in[11], 2, D, D, (bf16*)(ws + WS_WPOUT), scr, lane)) continue;
            if (p0_stack(it, args.in[17], 4, D, FF, (bf16*)(ws + WS_W1), scr, lane)) continue;
            if (p0_stack(it, args.in[18], 4, FF, D, (bf16*)(ws + WS_W2), scr, lane)) continue;
            if (p0_stack(it, args.in[12], 2, D, SFF, (bf16*)(ws + WS_WSIN), scr, lane)) continue;
            p0_stack(it, args.in[16], 2, SHALF, D, (bf16*)(ws + WS_WSOUT), scr, lane);
        }
        __syncthreads();
    }
#if MK_PER_PHASE_LAUNCH
    SEAM(0);
#else
    xcd_arrive2(bar, wave_s, 0u); __syncthreads(); ECHO_TICK(0);
#endif
    int vcu = bx, xl = 0;
#if !MK_PER_PHASE_LAUNCH
    {   bool ok = (G % 8) == 0; unsigned* bw = ctl + CW_BAR;
#pragma unroll
        for (int jx = 0; jx < 16; ++jx) { const unsigned cjx = xb_ld(&bw[XB_XCNT(jx)]); ok = ok && (cjx == (jx < 8 ? (unsigned)(G / 8) : 0u)); }
        const unsigned rk = MISC[10], xc = MISC[11];
        if (ok && xc < 8u && rk < (unsigned)(G / 8)) { vcu = (int)(rk * 8u + xc); xl = 1; }
        vcu = __builtin_amdgcn_readfirstlane(vcu); xl = __builtin_amdgcn_readfirstlane(xl);
    }
#endif
    if (IN(1) && !SKIP_P0) {
#if !MK_PER_PHASE_LAUNCH
        xcd_wait2(ctl + CW_BAR, 1u, wave_s, XB_SET(1));
#endif
        {
            const int gt = bx * (NWAVES * 64) + tid;
            if (gt < 8 * NBATCH * D) { const int r = gt / (NBATCH * D), b = (gt / D) % NBATCH, c = gt % D, li = r >> 1, sub = r & 1;
                GS[gt] = args.in[sub ? 5 : 4][(size_t)li * D + c] * (1.0f + MODV[((size_t)li * NBATCH + b) * (NMOD * D) + (sub ? 4 : 1) * D + c]); }
        }
        {
            LAS float* gs = (LAS float*)(lds + RING_OFF);
            for (int rb = bx; rb < T / 128; rb += G) {
                const int r0 = rb * 128, b = r0 < 8192 ? 0 : (r0 < 16384 ? 1 : 2);
                { const int c = tid * 4; const f32x4 gq = *(const f32x4*)(args.in[4] + c), sc = *(const f32x4*)(MODV + (size_t)b * (NMOD * D) + D + c); *(LAS f32x4*)(gs + c) = gq * (sc + 1.0f); }
                __syncthreads();
                for (int rr = 0; rr < 16; rr += 2) { const int row = r0 + wave * 16 + rr;
                    const float* src = row < 16384 ? args.in[0] + (size_t)row * D : args.in[1] + (size_t)(row - 16384) * D;
                    f32x4 v[2][8];
#pragma unroll
                    for (int h = 0; h < 2; ++h)
#pragma unroll
                        for (int q = 0; q < 4; ++q) { v[h][2 * q] = *(const f32x4*)(src + (size_t)h * D + q * 512 + lane * 8); v[h][2 * q + 1] = *(const f32x4*)(src + (size_t)h * D + q * 512 + lane * 8 + 4); }
#pragma unroll
                    for (int h = 0; h < 2; ++h) { float ss = 0.f;
#pragma unroll
                        for (int q = 0; q < 4; ++q) { const f32x4 x0 = v[h][2 * q], x1 = v[h][2 * q + 1];
                            ss += ((x0[0] * x0[0] + x0[1] * x0[1]) + (x0[2] * x0[2] + x0[3] * x0[3])) + ((x1[0] * x1[0] + x1[1] * x1[1]) + (x1[2] * x1[2] + x1[3] * x1[3]));
                            const f32x4 o0 = x0 * *(const LAS f32x4*)(gs + q * 512 + lane * 8), o1 = x1 * *(const LAS f32x4*)(gs + q * 512 + lane * 8 + 4);
                            v4u w; w.x = pk2(o0[0], o0[1]); w.y = pk2(o0[2], o0[3]); w.z = pk2(o1[0], o1[1]); w.w = pk2(o1[2], o1[3]); *(v4u*)(Hb + (size_t)(row + h) * D + q * 512 + lane * 8) = w; }
                        ss = wave_sum(ss, lane); if (lane == 0) ((unsigned*)SSX)[row + h] = (unsigned)(ss * pg8::SSQ_SCALE + 0.5f); } }
                __syncthreads(); }
        }
#if !MK_PER_PHASE_LAUNCH
        xcd_wait2(ctl + CW_BAR, 1u, wave_s, 0u);
#endif
        {
            LAS float* vec = (LAS float*)(lds + RING_OFF);
            const int gw = bx * NWAVES + wave, NGW = G * NWAVES;
            for (int hf = 0; hf < 2; ++hf) {
                __syncthreads();
                for (int u = tid; u < 4 * NBATCH * (D / 4); u += NWAVES * 64) { const int sx = u / (NBATCH * (D / 4)), r = u % (NBATCH * (D / 4)), b = r / (D / 4), d4 = r % (D / 4), id = hf * 4 + sx, li = id >> 1, which = id & 1;
                    *(LAS f32x4*)(vec + (size_t)u * 4) = *(const f32x4*)(MODV + ((size_t)li * NBATCH + b) * (NMOD * D) + (which ? 3 : 0) * D + d4 * 4); }
                __syncthreads();
                for (int sx = 0; sx < 4; ++sx) { const int id = hf * 4 + sx, li = id >> 1, which = id & 1;
                    const LAS float* vs = vec + sx * (NBATCH * D);
                    const int N = which ? FF : ((li & 1) ? SFF : D);
                    const bf16* Wt = which ? (const bf16*)(ws + WS_W1) + (size_t)li * FF * D : ((li & 1) ? (const bf16*)(ws + WS_WSIN) + (size_t)(li >> 1) * SFF * D : (const bf16*)(ws + WS_WPIN) + (size_t)(li >> 1) * D * D);
                    float* out = which ? CV1 + (size_t)li * NBATCH * FF : CVM + (size_t)li * NBATCH * SFF; const size_t ostride = which ? FF : SFF;
                    for (int n = gw; n < N; n += 2 * NGW) {
                        const int n2 = n + NGW; const bool two = n2 < N; const int n2c = two ? n2 : n;
                        v4u wA[4], wB[4];
#pragma unroll
                        for (int q = 0; q < 4; ++q) wA[q] = *(const v4u*)(Wt + (size_t)n * D + q * 512 + lane * 8);
#pragma unroll
                        for (int q = 0; q < 4; ++q) wB[q] = *(const v4u*)(Wt + (size_t)n2c * D + q * 512 + lane * 8);
                        float a0 = 0.f, a1 = 0.f, a2 = 0.f, b0 = 0.f, b1 = 0.f, b2 = 0.f;
#pragma unroll
                        for (int q = 0; q < 4; ++q) { const LAS float* vp = vs + q * 512 + lane * 8;
                            const float wf[8] = {bflo(wA[q].x), bfhi(wA[q].x), bflo(wA[q].y), bfhi(wA[q].y), bflo(wA[q].z), bfhi(wA[q].z), bflo(wA[q].w), bfhi(wA[q].w)};
                            const float wg[8] = {bflo(wB[q].x), bfhi(wB[q].x), bflo(wB[q].y), bfhi(wB[q].y), bflo(wB[q].z), bfhi(wB[q].z), bflo(wB[q].w), bfhi(wB[q].w)};
#pragma unroll
                            for (int e = 0; e < 8; ++e) { const float v0 = vp[e], v1 = vp[D + e], v2 = vp[2 * D + e]; a0 += wf[e] * v0; a1 += wf[e] * v1; a2 += wf[e] * v2; b0 += wg[e] * v0; b1 += wg[e] * v1; b2 += wg[e] * v2; } }
                        a0 = wave_sum(a0, lane); a1 = wave_sum(a1, lane); a2 = wave_sum(a2, lane); b0 = wave_sum(b0, lane); b1 = wave_sum(b1, lane); b2 = wave_sum(b2, lane);
                        if (lane == 0) { out[n] = a0; out[ostride + n] = a1; out[2 * ostride + n] = a2; if (two) { out[n2] = b0; out[ostride + n2] = b1; out[2 * ostride + n2] = b2; } }
                    }
                }
            }
            __syncthreads();
        }
        __syncthreads();
    }
    SEAM(1);

    for (int i = 0; i < DEPTH; ++i) {
        const int j = i >> 1, pb = 2 + i * 6;
        const float* modl = MODV + (size_t)i * NBATCH * (NMOD * D);
        const float* ss1 = SSX + (size_t)(2 * i) * T; float* ss2 = SSX + (size_t)(2 * i + 1) * T; float* ss3 = SSX + (size_t)(2 * i + 2) * T;
        const float* cvm = CVM + (size_t)i * NBATCH * SFF; const float* cv1 = CV1 + (size_t)i * NBATCH * FF;
        if ((i & 1) == 0) {
            bf16* Z = BIG + (size_t)640 * MiB / 2; bf16* ZD = BIG + (size_t)512 * MiB / 2; bf16* WO2 = (bf16*)(ws + WS_WSS);
            if (IN(pb + 0)) {
                pg8::Gemm g{Hb, (const bf16*)(ws + WS_WPIN) + (size_t)j * D * D, D, D, T, D, D, 0, 0}; pg8::StaticOrder S; S.init(T, D, G, opaque_s(vcu));
                pg8::EpiBf16<0, true> E{Z, D, nullptr, ss1, cvm, SFF, lds + TAB_OFF};
                pg8::gemm_phase<pg8::EpiBf16<0, true>, pg8::StaticOrder, true>(lds + RING_OFF, g, S, E, wave_s);
            }
#if MK_PER_PHASE_LAUNCH
            SEAM(pb + 0);
#else
            xcd_arrive2(bar, wave_s);
#endif
            if (IN(pb + 1) && !SKIP_POOL) {
                {
                    pg8::Gemm g{(const bf16*)(ws + WS_WPOUT) + (size_t)j * D * D, (const bf16*)(ws + WS_WPGRP) + (size_t)j * D * PGRP, D, PGRP, D, D, PGRP, 1, PGRP}; pg8::StaticOrder S; S.init(D, D, G, opaque_s(vcu));
                    pg8::EpiBf16<0, false> E{WO2, D, nullptr, nullptr, nullptr, 0, lds + TAB_OFF};
                    pg8::gemm_phase<pg8::EpiBf16<0, false>, pg8::StaticOrder, true>(lds + RING_OFF, g, S, E, wave_s);
                }
#if !MK_PER_PHASE_LAUNCH
                xcd_wait2(ctl + CW_BAR, (unsigned)(i + 2), wave_s); ECHO_TICK(pb + 0);
#endif
                const int tid = otid(wave_s);
                int bxo = bx; asm volatile("" : "+s"(bxo));
                for (int seg = bxo; seg < T / 128; seg += G) {
                    const int half = tid >> 8, chunk = tid & 255, gsel = chunk >> 6, hw = 1 << gsel;
                    const int r0 = seg * 128 + half * 64;
                    const int s0 = r0 < 8192 ? 0 : (r0 < 16384 ? 8192 : 16384), s1 = r0 < 8192 ? 8192 : (r0 < 16384 ? 16384 : 32768);
                    const bf16* zc = Z + chunk * 8; bf16* oc = ZD + chunk * 8;
                    float sum[8];
#pragma unroll
                    for (int q = 0; q < 8; ++q) sum[q] = 0.f;
                    for (int t = r0 - hw; t <= r0 + hw - 1; ++t) if (t >= s0 && t < s1) { const v4u w = *(const v4u*)(zc + (size_t)t * D);
                        sum[0] += bflo(w.x); sum[1] += bfhi(w.x); sum[2] += bflo(w.y); sum[3] += bfhi(w.y); sum[4] += bflo(w.z); sum[5] += bfhi(w.z); sum[6] += bflo(w.w); sum[7] += bfhi(w.w); }
#pragma unroll 8
                    for (int t = r0; t < r0 + 64; ++t) {
                        const int lo_t = (t - hw > s0) ? t - hw : s0, hi_t = (t + hw - 1 < s1 - 1) ? t + hw - 1 : s1 - 1;
                        const float inv = 1.0f / (float)(hi_t - lo_t + 1);
                        const v4u zc4 = *(const v4u*)(zc + (size_t)t * D);
                        v4u add = {0u, 0u, 0u, 0u}, sub = {0u, 0u, 0u, 0u};
                        if (t + hw < s1) add = *(const v4u*)(zc + (size_t)(t + hw) * D);
                        if (t - hw >= s0) sub = *(const v4u*)(zc + (size_t)(t - hw) * D);
                        v4u o;
                        o.x = pk2(sum[0] * inv - bflo(zc4.x), sum[1] * inv - bfhi(zc4.x)); o.y = pk2(sum[2] * inv - bflo(zc4.y), sum[3] * inv - bfhi(zc4.y));
                        o.z = pk2(sum[4] * inv - bflo(zc4.z), sum[5] * inv - bfhi(zc4.z)); o.w = pk2(sum[6] * inv - bflo(zc4.w), sum[7] * inv - bfhi(zc4.w));
                        *(v4u*)(oc + (size_t)t * D) = o;
                        sum[0] += bflo(add.x) - bflo(sub.x); sum[1] += bfhi(add.x) - bfhi(sub.x); sum[2] += bflo(add.y) - bflo(sub.y); sum[3] += bfhi(add.y) - bfhi(sub.y);
                        sum[4] += bflo(add.z) - bflo(sub.z); sum[5] += bfhi(add.z) - bfhi(sub.z); sum[6] += bflo(add.w) - bflo(sub.w); sum[7] += bfhi(add.w) - bfhi(sub.w);
                    }
                }
            }
            SEAM(pb + 1);
            if (IN(pb + 3)) {
                pg8::Gemm g{ZD, WO2, D, D, T, D, D, 0, 0}; pg8::StaticOrder S; S.init(T, D, G, opaque_s(vcu), 4, 1);
                pg8::EpiResid E{X, D, modl + 2 * D, NMOD * D, Hb, GS + (size_t)(2 * i + 1) * NBATCH * D, D, ss2, i == 0 ? args.in[0] : (const float*)nullptr, args.in[1]};
                pg8::gemm_phase<pg8::EpiResid, pg8::StaticOrder, true>(lds + RING_OFF, g, S, E, wave_s);
            }
#if MK_PER_PHASE_LAUNCH
            SEAM(pb + 3);
#else
            if (xl) xcd_local_barrier(bar, wave_s); else GRID_BAR(); ECHO_TICK(pb + 3);
#endif
        } else {
            bf16* Gt = BIG; bf16* VT = BIG + (size_t)T * SHALF; bf16* WsS = (bf16*)(ws + WS_WSS);
            const bf16* wsin = (const bf16*)(ws + WS_WSIN) + (size_t)j * SFF * D;
            if (IN(pb + 0)) {
                pg8::Gemm g{wsin + (size_t)SHALF * D, Hb, D, D, SHALF, T, D, 0, 0}; pg8::StaticOrder S; S.init(SHALF, T, G, opaque_s(vcu), 8);
                pg8::EpiVT E{VT, VTLD, SSP, T, ss1, cvm + SHALF, SFF, lds + TAB_OFF};
                pg8::gemm_phase<pg8::EpiVT, pg8::StaticOrder, true>(lds + RING_OFF, g, S, E, wave_s);
            }
            SEAM(pb + 0);
            if (IN(pb + 1) && !SKIP_GATE) {
                LAS float* rinv = (LAS float*)(lds + RING_OFF);
                const float* w_s = args.in[14] + (size_t)j * NHEADS * CHUNK * CHUNK;
                const int tid = otid(wave_s);
                int bxo = bx; asm volatile("" : "+s"(bxo));
                for (int n = bxo; n < T / CHUNK; n += G) {
                    if (tid < CHUNK) { float sacc = 0.f;
#pragma unroll
                        for (int k = 0; k < NSSP; ++k) sacc += SSP[(size_t)k * T + n * CHUNK + tid];
                        rinv[tid] = 1.0f / sqrtf(sacc * (1.0f / SHALF) + EPS); }
                    __syncthreads();
#pragma unroll 8
                    for (int it = 0; it < 32; ++it) { const int h = it >> 2, unit = (it & 3) * 512 + tid, p = unit >> 4, q8 = unit & 15;
                        const float* wp = w_s + (size_t)h * CHUNK * CHUNK + p * CHUNK + q8 * 8;
                        const f32x4 w0 = *(const f32x4*)wp * *(const LAS f32x4*)(rinv + q8 * 8), w1 = *(const f32x4*)(wp + 4) * *(const LAS f32x4*)(rinv + q8 * 8 + 4);
                        v4u o; o.x = pk2(w0[0], w0[1]); o.y = pk2(w0[2], w0[3]); o.z = pk2(w1[0], w1[1]); o.w = pk2(w1[2], w1[3]);
                        *(v4u*)(WsS + ((((size_t)(n * 8 + h) * 8 + (p >> 4)) * 4 + (q8 >> 2)) * 64 + (q8 & 3) * 16 + (p & 15)) * 8) = o; }
                    __syncthreads();
                }
            }
#if MK_PER_PHASE_LAUNCH
            SEAM(pb + 1);
#else
            xcd_arrive2(bar, wave_s); ECHO_TICK(pb + 1);
#endif
            if (IN(pb + 2)) {
                pg8::Gemm g{Hb, wsin, D, D, T, SHALF, D, 0, 0}; pg8::StaticOrder S; S.init(T, SHALF, G, opaque_s(vcu));
                pg8::EpiGate E{Gt, SHALF, VT, VTLD, WsS, args.in[13] + (size_t)j * SHALF, args.in[15] + (size_t)j * NHEADS * CHUNK, lds, ss1, cvm, SFF, lds + TAB_OFF, MK_PER_PHASE_LAUNCH ? (unsigned*)nullptr : ctl + CW_BAR, (unsigned)(i + 2)};
                pg8::gemm_phase<pg8::EpiGate, pg8::StaticOrder, true>(lds + RING_OFF, g, S, E, wave_s);
            }
#if MK_PER_PHASE_LAUNCH
            SEAM(pb + 2);
#else
            if (xl) xcd_local_barrier(bar, wave_s); else GRID_BAR(); ECHO_TICK(pb + 2);
#endif
            if (IN(pb + 3)) {
                pg8::Gemm g{Gt, (const bf16*)(ws + WS_WSOUT) + (size_t)j * D * SHALF, SHALF, SHALF, T, D, SHALF, 0, 0}; pg8::StaticOrder S; S.init(T, D, G, opaque_s(vcu), 4, 1);
                pg8::EpiResid E{X, D, modl + 2 * D, NMOD * D, Hb, GS + (size_t)(2 * i + 1) * NBATCH * D, D, ss2, nullptr, nullptr};
                pg8::gemm_phase<pg8::EpiResid, pg8::StaticOrder, true>(lds + RING_OFF, g, S, E, wave_s);
            }
            SEAM(pb + 3);
        }

        bf16* A2 = BIG;
        if (IN(pb + 4)) {
            pg8::Gemm g{Hb, (const bf16*)(ws + WS_W1) + (size_t)i * FF * D, D, D, T, FF, D, 0, 0}; pg8::StaticOrder S; S.init(T, FF, G, opaque_s(vcu));
            pg8::EpiBf16<2, true> E{A2, FF, nullptr, ss2, cv1, FF, lds + TAB_OFF};
            pg8::gemm_phase<pg8::EpiBf16<2, true>, pg8::StaticOrder, true>(lds + RING_OFF, g, S, E, wave_s);
        }
#if MK_PER_PHASE_LAUNCH
        SEAM(pb + 4);
#else
        if (xl) xcd_local_barrier(bar, wave_s); else GRID_BAR(); ECHO_TICK(pb + 4);
#endif
        if (IN(pb + 5)) {
            pg8::Gemm g{A2, (const bf16*)(ws + WS_W2) + (size_t)i * D * FF, FF, FF, T, D, FF, 0, 0}; pg8::StaticOrder S; S.init(T, D, G, opaque_s(vcu), 4, 1);
            pg8::EpiResid E{X, D, modl + 5 * D, NMOD * D, (i + 1 < DEPTH) ? Hb : (bf16*)nullptr, GS + (size_t)(2 * i + 2 < 8 ? 2 * i + 2 : 0) * NBATCH * D, D, ss3, nullptr, nullptr};
            pg8::gemm_phase<pg8::EpiResid, pg8::StaticOrder, true>(lds + RING_OFF, g, S, E, wave_s);
        }
#if MK_PER_PHASE_LAUNCH
        SEAM(pb + 5);
#else
        if (xl && (i == 1 || i == DEPTH - 1)) xcd_local_barrier(bar, wave_s); else GRID_BAR(); ECHO_TICK(pb + 5);
#endif
    }

    if (IN(2 + DEPTH * 6)) {
        const float* fg = args.in[19];
        const int tid = otid(wave_s), lane = tid & 63, wave = __builtin_amdgcn_readfirstlane(tid >> 6);
        const int xq = vcu & 7, rq = vcu >> 3;
        const int rs = xl ? xq * (T / 8) + rq * NWAVES + wave : bx * NWAVES + wave, rstride = xl ? (G / 8) * NWAVES : G * NWAVES, rend = xl ? (xq + 1) * (T / 8) : T;
        for (int row = rs; row < rend; row += 2 * rstride) {
            const bool two = row + rstride < rend; const int row2 = two ? row + rstride : row;
            v4u w[4], w2[4];
#pragma unroll
            for (int q = 0; q < 4; ++q) w[q] = *(const v4u*)(X + (size_t)row * D + q * 512 + lane * 8);
#pragma unroll
            for (int q = 0; q < 4; ++q) w2[q] = *(const v4u*)(X + (size_t)row2 * D + q * 512 + lane * 8);
#pragma unroll
            for (int h = 0; h < 2; ++h) { if (h == 1 && !two) continue; float* orow = args.out + (size_t)(h ? row2 : row) * D; float ss = 0.f;
                f32x4 v[8];
#pragma unroll
                for (int q = 0; q < 4; ++q) { const v4u ww = h ? w2[q] : w[q]; v[2 * q] = (f32x4){bflo(ww.x), bfhi(ww.x), bflo(ww.y), bfhi(ww.y)}; v[2 * q + 1] = (f32x4){bflo(ww.z), bfhi(ww.z), bflo(ww.w), bfhi(ww.w)}; }
#pragma unroll
                for (int q = 0; q < 8; ++q) ss += (v[q][0] * v[q][0] + v[q][1] * v[q][1]) + (v[q][2] * v[q][2] + v[q][3] * v[q][3]);
                const float rinv = 1.0f / sqrtf(wave_sum(ss, lane) * (1.0f / D) + EPS);
#pragma unroll
                for (int q = 0; q < 8; ++q) { const int c = (q >> 1) * 512 + lane * 8 + (q & 1) * 4; const f32x4 g4 = *(const f32x4*)(fg + c); *(f32x4*)(orow + c) = v[q] * rinv * g4; } }
        }
    }
    if (ECHO_MASK) { ECHO_TICK(2 + DEPTH * 6);
        if (bx == 0 && otid(wave_s) < 64) { const unsigned long long t_end = __builtin_amdgcn_s_memrealtime() + (unsigned long long)ECHO_MUL * echo_acc; while (__builtin_amdgcn_s_memrealtime() < t_end) __builtin_amdgcn_s_sleep(8); } }
#undef IN
#undef SEAM
}

extern "C" void kernel_launch(void* const* d_in, const int* in_sizes, int n_in, void* d_out, int out_size, void* d_ws, size_t ws_size, hipStream_t stream) {
    static int grid = 0;
    if (grid == 0) {
        if (n_in != 20 || out_size != T * D || ws_size < WS_END) { fprintf(stderr, "kernel_launch: built for 20 inputs, out of %d floats, >= %zu bytes of workspace; got n_in %d, out %d, ws %zu; nothing launched\n", T * D, (size_t)WS_END, n_in, out_size, ws_size); grid = -1; return; }
        int dev = 0, cus = 0, per_cu = 0;
        if (hipGetDevice(&dev) != hipSuccess || hipDeviceGetAttribute(&cus, hipDeviceAttributeMultiprocessorCount, dev) != hipSuccess) { fprintf(stderr, "kernel_launch: hipGetDevice / hipDeviceGetAttribute failed\n"); grid = -1; return; }
        if (hipFuncSetAttribute((const void*)enc_fwd, hipFuncAttributeMaxDynamicSharedMemorySize, LDS_BYTES) != hipSuccess) { fprintf(stderr, "kernel_launch: hipFuncSetAttribute failed\n"); grid = -1; return; }
        if (hipOccupancyMaxActiveBlocksPerMultiprocessor(&per_cu, (const void*)enc_fwd, NWAVES * 64, LDS_BYTES) != hipSuccess || per_cu < 1) { fprintf(stderr, "kernel_launch: occupancy query reports %d workgroups per CU\n", per_cu); }
        (void)hipGetLastError();
        grid = cus;
    }
    if (grid < 0) return;
    if (hipMemsetAsync((char*)d_ws + WS_CTL, 0, CTL_ZERO_BYTES, stream) != hipSuccess) { fprintf(stderr, "kernel_launch: hipMemsetAsync failed\n"); return; }
    Args a{};
    for (int i = 0; i < 20; ++i) a.in[i] = (const float*)d_in[i];
    a.out = (float*)d_out; a.ws = (unsigned char*)d_ws;
    constexpr int NPH = 3 + DEPTH * 6;
#if MK_PER_PHASE_LAUNCH
    for (int p = 0; p < NPH; ++p) { a.ph_lo = p; a.ph_hi = p + 1; hipLaunchKernelGGL(enc_fwd, dim3(grid), dim3(NWAVES * 64), LDS_BYTES, stream, a); }
#else
    a.ph_lo = 0; a.ph_hi = NPH;
    hipLaunchKernelGGL(enc_fwd, dim3(grid), dim3(NWAVES * 64), LDS_BYTES, stream, a);
#endif
    const hipError_t le = hipPeekAtLastError();
    if (le != hipSuccess) fprintf(stderr, "kernel_launch: launch failed: %s\n", hipGetErrorName(le));
}
```

```cpp
#include <hip/hip_runtime.h>
#include <cstdio>
#include <cstdint>

#ifndef SKIP_NORM
#define SKIP_NORM 0
#endif
#ifndef SKIP_POOL
#define SKIP_POOL 0
#endif
#ifndef SKIP_GATE
#define SKIP_GATE 0
#endif
#ifndef SKIP_P0
#define SKIP_P0 0
#endif
#ifndef ECHO_MASK
#define ECHO_MASK 0ull
#endif
#ifndef ECHO_MUL
#define ECHO_MUL 1
#endif
#ifndef MK_PER_PHASE_LAUNCH
#define MK_PER_PHASE_LAUNCH 0
#endif

__device__ __forceinline__ void xcd_wait2(unsigned* bar_, unsigned target, int wid, unsigned setoff = 0u);
namespace pg8 {
#define PG8_LAS __attribute__((address_space(3)))
typedef unsigned short bf16_t;
typedef short bf16x8 __attribute__((ext_vector_type(8)));
typedef float f32x4 __attribute__((ext_vector_type(4)));
typedef float f32x2 __attribute__((ext_vector_type(2)));
typedef unsigned u32x4 __attribute__((ext_vector_type(4)));
constexpr int BM = 256, BK = 64, HALF = 128, HTB = HALF * BK * 2  , STAGE_BYTES = 8 * HTB, NXCD = 8;

__host__ __device__ __forceinline__ int lds_byte(int r, int c) { const int st = (r >> 4) * 2 + (c >> 5), rr = r & 15, cc = c & 31, ob = rr * 64 + cc * 2; return st * 1024 + (ob ^ (((ob >> 9) & 1) << 5)); }
__host__ __device__ __forceinline__ void stage_rc(int b, int& R, int& C) { const int st = b / 1024, sb = b % 1024, swz = sb ^ (((sb >> 9) & 1) << 5); R = (st >> 1) * 16 + swz / 64; C = (st & 1) * 32 + (swz % 64) / 2; }
__host__ __device__ __forceinline__ int perm32(int rho) { const int n = rho >> 4, i = rho & 15; return 8 * (i >> 2) + 4 * n + (i & 3); }

struct Unit { int pm, pn; };
struct Gemm { const bf16_t* A; const bf16_t* Bt; int lda, ldb, M, N, K, a_kshift, a_kcols; };

struct StaticOrder {
    int nM, nN, nwg, G, c, WGM, rev;
    __host__ __device__ void init(int M, int N, int G_, int c_, int wgm = 4, int rev_ = 0) { nM = M / BM; nN = N / BM; nwg = nM * nN; G = G_; c = c_; WGM = wgm; rev = (rev_ && nwg % G_ == 0) ? nwg / G_ : 0; }
    __host__ __device__ bool next(int i, Unit& u) const {
        const long L = (long)(rev ? rev - 1 - i : i) * G + c; if (i < 0 || L < 0 || L >= nwg) return false;
        int wgid = (int)L; { const int q = nwg / NXCD, r = nwg % NXCD, xcd = wgid % NXCD, off = wgid / NXCD; wgid = (xcd < r ? xcd * (q + 1) : r * (q + 1) + (xcd - r) * q) + off; }
        const int nig = WGM * nN, gid = wgid / nig, fm = gid * WGM, gsz = (nM - fm) < WGM ? (nM - fm) : WGM;
        u.pm = fm + ((wgid % nig) % gsz); u.pn = (wgid % nig) / gsz; return true;
    }
    __device__ __forceinline__ void a_ready(const Unit&) const {}
    __device__ __forceinline__ void done(const Unit&) const {}
};

__device__ __forceinline__ int lane_asm() { int l; asm volatile("v_mbcnt_lo_u32_b32 %0, -1, 0\n\tv_mbcnt_hi_u32_b32 %0, -1, %0" : "=v"(l)); return l; }
__device__ __forceinline__ float shfl_xor_l(float v, int mask, int lane) { return __builtin_bit_cast(float, __builtin_amdgcn_ds_bpermute((lane ^ mask) << 2, __builtin_bit_cast(int, v))); }
__device__ __forceinline__ float row_sum16(float v) {
    v += __builtin_bit_cast(float, __builtin_amdgcn_update_dpp(0, __builtin_bit_cast(int, v), 0x111, 0xf, 0xf, true));
    v += __builtin_bit_cast(float, __builtin_amdgcn_update_dpp(0, __builtin_bit_cast(int, v), 0x112, 0xf, 0xf, true));
    v += __builtin_bit_cast(float, __builtin_amdgcn_update_dpp(0, __builtin_bit_cast(int, v), 0x114, 0xf, 0xf, true));
    v += __builtin_bit_cast(float, __builtin_amdgcn_update_dpp(0, __builtin_bit_cast(int, v), 0x118, 0xf, 0xf, true));
    return v;
}
__device__ __forceinline__ unsigned cvt_pk_bf16(float lo, float hi) { unsigned r; asm volatile("v_cvt_pk_bf16_f32 %0, %1, %2" : "=v"(r) : "v"(lo), "v"(hi)); return r; }
__device__ __forceinline__ f32x2 gelu_pk(f32x2 v) {
    f32x2 a; a.x = __builtin_fminf(__builtin_fabsf(v.x), 6.0f); a.y = __builtin_fminf(__builtin_fabsf(v.y), 6.0f);
    f32x2 p = a * 5.38297500e-06f + 4.88906356e-05f; p = p * a + 3.80035750e-05f; p = p * a + 3.27762633e-03f; p = p * a + 2.11410062e-02f; p = p * a + 4.98673470e-02f; p = p * a + 1.0f;
    p = p * p; p = p * p; p = p * p; p = p * p;
    const float m = p.x * p.y, rr = __builtin_amdgcn_rcpf(m + m);
    f32x2 q; q.x = rr * p.y; q.y = rr * p.x;
    const f32x2 z = {0.f, 0.f};
    return __builtin_elementwise_max(v, z) - a * q;
}
__device__ __forceinline__ f32x4 gelu4(f32x4 v) { const f32x2 a = gelu_pk((f32x2){v[0], v[1]}), b = gelu_pk((f32x2){v[2], v[3]}); return (f32x4){a.x, a.y, b.x, b.y}; }

__device__ __forceinline__ int batch_of_tile(int p) { return p < 32 ? 0 : (p < 64 ? 1 : 2); }
constexpr float SSQ_SCALE = 1024.0f, SSQ_INV = 1.0f / 1024.0f;
__device__ __forceinline__ void norm_prefetch(const float* rowsrc, const float* colsrc, PG8_LAS unsigned char* tab, int wid) {
    const int lane = lane_asm(), part = wid & 3;
    const float* src = ((wid >> 2) ? colsrc : rowsrc) + part * 64 + lane;
    __builtin_amdgcn_global_load_lds((const unsigned*)src, (PG8_LAS unsigned*)(tab + (wid >> 2) * 1024 + part * 256), 4, 0, 0);
}
template <bool SWAPPED>
__device__ __forceinline__ void norm_prepass(f32x4 (&acc)[2][2][4][2], const PG8_LAS unsigned char* tab, float inv_nd, float eps, int wr, int wc, int fr, int fq) {
    const PG8_LAS float* rt = (const PG8_LAS float*)tab + wr * 64 + fr; const PG8_LAS float* ct = (const PG8_LAS float*)(tab + 1024) + wc * 32 + 8 * fq;
    f32x4 cvv[2][2];
#pragma unroll
    for (int bj = 0; bj < 2; ++bj)
#pragma unroll
        for (int n = 0; n < 2; ++n) { f32x4 q = *(const PG8_LAS f32x4*)(ct + bj * HALF + 4 * n);
            if (SWAPPED) { const u32x4 qi = __builtin_bit_cast(u32x4, q); q = (f32x4){(float)qi[0], (float)qi[1], (float)qi[2], (float)qi[3]} * (SSQ_INV * inv_nd) + eps; q = (f32x4){__builtin_amdgcn_rsqf(q[0]), __builtin_amdgcn_rsqf(q[1]), __builtin_amdgcn_rsqf(q[2]), __builtin_amdgcn_rsqf(q[3])}; }
            cvv[bj][n] = q; }
#pragma unroll
    for (int ai = 0; ai < 2; ++ai)
#pragma unroll
        for (int m = 0; m < 4; ++m) { float r = rt[ai * HALF + m * 16]; if (!SWAPPED) r = __builtin_amdgcn_rsqf((float)__builtin_bit_cast(unsigned, r) * (SSQ_INV * inv_nd) + eps);
#pragma unroll
            for (int bj = 0; bj < 2; ++bj) { if (SWAPPED) { acc[ai][bj][m][0] = acc[ai][bj][m][0] * cvv[bj][0] + r; acc[ai][bj][m][1] = acc[ai][bj][m][1] * cvv[bj][1] + r; }
                                             else         { acc[ai][bj][m][0] = acc[ai][bj][m][0] * r + cvv[bj][0]; acc[ai][bj][m][1] = acc[ai][bj][m][1] * r + cvv[bj][1]; } } }
}
template <int ACT, bool NORMED> struct EpiBf16 {
    static constexpr bool PERM = true;
    static constexpr bool PREF = NORMED, RESTAGE = false;
    bf16_t* O; int ldc; const float* cs; const float* nss; const float* ncv; int ncvstride; PG8_LAS unsigned char* tabs;
    __device__ __forceinline__ void prefetch(const Unit& u, int wid, int buf) const { norm_prefetch(nss + u.pm * BM, ncv + (size_t)batch_of_tile(u.pm) * ncvstride + u.pn * BM, tabs + buf * 2048, wid); }
    __device__ __forceinline__ void operator()(f32x4 (&acc)[2][2][4][2], const Unit& u, int wr, int wc, int fr, int fq, int buf) const {
        if constexpr (NORMED) norm_prepass<false>(acc, tabs + buf * 2048, 1.0f / 2048.0f, 1e-6f, wr, wc, fr, fq);
        const int row0 = u.pm * BM + wr * 64 + fr, col0 = u.pn * BM + wc * 32 + 8 * fq;
        f32x4 sv[2][2];
#pragma unroll
        for (int bj = 0; bj < 2; ++bj)
#pragma unroll
            for (int n = 0; n < 2; ++n) sv[bj][n] = (ACT == 3) ? *(const f32x4*)(cs + col0 + bj * HALF + 4 * n) : (f32x4){1.f, 1.f, 1.f, 1.f};
#pragma unroll
        for (int ai = 0; ai < 2; ++ai)
#pragma unroll
            for (int m = 0; m < 4; ++m) { bf16_t* rowp = O + (size_t)(row0 + ai * HALF + m * 16) * ldc + col0;
#pragma unroll
                for (int bj = 0; bj < 2; ++bj) { f32x4 v0 = acc[ai][bj][m][0], v1 = acc[ai][bj][m][1];
                    if (ACT == 1) { v0 = gelu4(v0); v1 = gelu4(v1); }
                    if (ACT == 2) { v0 = __builtin_elementwise_max(v0, (f32x4){0.f, 0.f, 0.f, 0.f}); v1 = __builtin_elementwise_max(v1, (f32x4){0.f, 0.f, 0.f, 0.f}); v0 = v0 * v0; v1 = v1 * v1; }
                    if (ACT == 3) { v0 = v0 * sv[bj][0]; v1 = v1 * sv[bj][1]; }
                    u32x4 w; w.x = cvt_pk_bf16(v0[0], v0[1]); w.y = cvt_pk_bf16(v0[2], v0[3]); w.z = cvt_pk_bf16(v1[0], v1[1]); w.w = cvt_pk_bf16(v1[2], v1[3]);
                    *(u32x4*)(rowp + bj * HALF) = w; } }
    }
};
struct EpiVT {
    static constexpr bool PERM = true;
    static constexpr bool PREF = true, RESTAGE = false;
    bf16_t* VT; int ldt; float* ssp; int ssld; const float* nss; const float* ncv; int ncvstride; PG8_LAS unsigned char* tabs;
    __device__ __forceinline__ void prefetch(const Unit& u, int wid, int buf) const { norm_prefetch(ncv + (size_t)batch_of_tile(u.pn) * ncvstride + u.pm * BM, nss + u.pn * BM, tabs + buf * 2048, wid); }
    __device__ __forceinline__ void operator()(f32x4 (&acc)[2][2][4][2], const Unit& u, int wr, int wc, int fr, int fq, int buf) const {
        const int row0 = u.pm * BM + wr * 64 + fr, col0 = u.pn * BM + wc * 32 + 8 * fq;
        norm_prepass<true>(acc, tabs + buf * 2048, 1.0f / 2048.0f, 1e-6f, wr, wc, fr, fq);
        f32x4 ss[2][2];
#pragma unroll
        for (int bj = 0; bj < 2; ++bj)
#pragma unroll
            for (int n = 0; n < 2; ++n) ss[bj][n] = (f32x4){0.f, 0.f, 0.f, 0.f};
#pragma unroll
        for (int ai = 0; ai < 2; ++ai)
#pragma unroll
            for (int m = 0; m < 4; ++m) { bf16_t* rowp = VT + (size_t)(row0 + ai * HALF + m * 16) * ldt + col0;
#pragma unroll
                for (int bj = 0; bj < 2; ++bj) { const f32x4 v0 = gelu4(acc[ai][bj][m][0]), v1 = gelu4(acc[ai][bj][m][1]);
                    ss[bj][0] += v0 * v0; ss[bj][1] += v1 * v1;
                    u32x4 w; w.x = cvt_pk_bf16(v0[0], v0[1]); w.y = cvt_pk_bf16(v0[2], v0[3]); w.z = cvt_pk_bf16(v1[0], v1[1]); w.w = cvt_pk_bf16(v1[2], v1[3]);
                    *(u32x4*)(rowp + bj * HALF) = w; } }
#pragma unroll
        for (int bj = 0; bj < 2; ++bj)
#pragma unroll
            for (int n = 0; n < 2; ++n)
#pragma unroll
                for (int j = 0; j < 4; ++j) ss[bj][n][j] = row_sum16(ss[bj][n][j]);
        if (fr == 15) { float* p = ssp + (size_t)(u.pm * 2 + wr) * ssld + col0;
#pragma unroll
            for (int bj = 0; bj < 2; ++bj) { *(f32x4*)(p + bj * HALF) = ss[bj][0]; *(f32x4*)(p + bj * HALF + 4) = ss[bj][1]; } }
    }
};
struct EpiGate {
    static constexpr bool PERM = true;
    static constexpr bool PREF = true;
    static constexpr bool RESTAGE = true;
    static constexpr int SB0 = 131072, SB1 = 32768, SB2 = 98304, GTAB = 57344;
    bf16_t* Gt; int ldc; const bf16_t* VT; int ldt; const bf16_t* WsS; const float* gain; const float* b_s; PG8_LAS unsigned char* lb; const float* nss; const float* ncv; int ncvstride; PG8_LAS unsigned char* tabs; unsigned* lbar; unsigned ltarget;
    __device__ __forceinline__ void prefetch(const Unit& u, int wid, int buf) const { norm_prefetch(nss + u.pm * BM, ncv + (size_t)batch_of_tile(u.pm) * ncvstride + u.pn * BM, tabs + buf * 2048, wid); }
    __device__ __forceinline__ void late_wait(int wid) const { if (lbar) ::xcd_wait2(lbar, ltarget, wid); }
    __device__ __forceinline__ void operator()(f32x4 (&acc)[2][2][4][2], const Unit& u, int wr, int wc, int fr_, int fq_, int buf) const {
        int fr = fr_, fq = fq_; asm volatile("" : "+v"(fr), "+v"(fq));
        const int wid = wr * 4 + wc, h = u.pn / 3;
#define PG8_GSB(k) (((k) % 3) == 0 ? SB0 : (((k) % 3) == 1 ? SB1 : SB2))
#define PG8_GADDR() const int lane = fq * 16 + fr; \
        const unsigned voff = ((unsigned)(u.pn * BM + wr * HALF + wc * 32 + 8 * (fr >> 2) + (fr & 3)) * (unsigned)ldt + 8u * fq + (unsigned)(2 * u.pm) * 128u) * 2u; \
        const unsigned woff = ((unsigned)(((2 * u.pm) * 8 + h) * 8 + wid) * 2048u + lane * 8u) * 2u; const unsigned vrow4 = (unsigned)ldt * 8u
#define PG8_GISSUE(k) do { const int ai_ = (k) >> 2, kb_ = (k) & 3; PG8_LAS unsigned char* d_ = lb + PG8_GSB(k); \
            __builtin_amdgcn_global_load_lds((const unsigned*)((const char*)WsS + (woff + (unsigned)(ai_ * (8 * 8 * 2048) + kb_ * 512) * 2u)), (PG8_LAS unsigned*)(d_ + wid * 1024), 16, 0, 0); \
            __builtin_amdgcn_global_load_lds((const unsigned*)((const char*)VT + (voff + (unsigned)(ai_ * 128 + kb_ * 32) * 2u)), (PG8_LAS unsigned*)(d_ + 8192 + (wid * 2) * 1024), 16, 0, 0); \
            __builtin_amdgcn_global_load_lds((const unsigned*)((const char*)VT + (voff + vrow4 + (unsigned)(ai_ * 128 + kb_ * 32) * 2u)), (PG8_LAS unsigned*)(d_ + 8192 + (wid * 2) * 1024 + 1024), 16, 0, 0); } while (0)
        {   PG8_GADDR();
            PG8_GISSUE(0);
            if (wid < 4) __builtin_amdgcn_global_load_lds((const unsigned*)(gain + u.pn * BM + wid * 64 + lane), (PG8_LAS unsigned*)(lb + GTAB + wid * 256), 4, 0, 0);
            else if (wid < 6) __builtin_amdgcn_global_load_lds((const unsigned*)(b_s + h * 128 + (wid - 4) * 64 + lane), (PG8_LAS unsigned*)(lb + GTAB + 1024 + (wid - 4) * 256), 4, 0, 0);
            PG8_GISSUE(1); PG8_GISSUE(2); }
        __builtin_amdgcn_sched_barrier(0);
        norm_prepass<false>(acc, tabs + buf * 2048, 1.0f / 2048.0f, 1e-6f, wr, wc, fr, fq);
        __builtin_amdgcn_sched_barrier(0);
        asm volatile("" : "+v"(fr), "+v"(fq));
        PG8_GADDR();
        const int rwo = (4 * wr) * 1024 + lane * 16, rvo = 8192 + (wc * 2) * 1024 + lane * 16;
        f32x4 mx[2][4][2];
#define PG8_GGELU(ai, kb, q) do { constexpr int bjg_ = (kb) >> 1, mg_ = 2 * ((kb) & 1) + ((q) >> 1), ng_ = (q) & 1; acc[ai][bjg_][mg_][ng_] = gelu4(acc[ai][bjg_][mg_][ng_]); asm volatile("" : "+v"(acc[ai][bjg_][mg_][ng_])); } while (0)
#define PG8_GMMA(m, W) do { _Pragma("unroll") for (int bj = 0; bj < 2; ++bj) { mx[bj][m][0] = __builtin_amdgcn_mfma_f32_16x16x32_bf16(vtf[bj][0], W, mx[bj][m][0], 0, 0, 0); \
                                                                            mx[bj][m][1] = __builtin_amdgcn_mfma_f32_16x16x32_bf16(vtf[bj][1], W, mx[bj][m][1], 0, 0, 0); } } while (0)
#define PG8_GSTEP(k, WAITN) do { constexpr int ai = (k) >> 2, kb = (k) & 3; \
            asm volatile("s_waitcnt lgkmcnt(0)" ::: "memory"); asm volatile("s_waitcnt vmcnt(" #WAITN ")" ::: "memory"); __builtin_amdgcn_s_barrier(); asm volatile("" ::: "memory"); \
            if ((k) >= 1 && (k) + 2 <= 7) PG8_GISSUE(((k) >= 1 && (k) + 2 <= 7) ? (k) + 2 : 7); __builtin_amdgcn_sched_barrier(0); \
            if (kb == 0) { _Pragma("unroll") for (int bj = 0; bj < 2; ++bj) _Pragma("unroll") for (int m = 0; m < 4; ++m) { mx[bj][m][0] = (f32x4){0.f, 0.f, 0.f, 0.f}; mx[bj][m][1] = (f32x4){0.f, 0.f, 0.f, 0.f}; } } \
            { const PG8_LAS unsigned char* rw = lb + PG8_GSB(k) + rwo; const PG8_LAS unsigned char* rv = lb + PG8_GSB(k) + rvo; \
              bf16x8 vtf[2][2], wsfA, wsfB; \
              _Pragma("unroll") for (int bj = 0; bj < 2; ++bj) { vtf[bj][0] = *(const PG8_LAS bf16x8*)(rv + bj * 8192); vtf[bj][1] = *(const PG8_LAS bf16x8*)(rv + bj * 8192 + 1024); } \
              wsfA = *(const PG8_LAS bf16x8*)(rw); __builtin_amdgcn_sched_barrier(0); \
              PG8_GGELU(ai, kb, 0); __builtin_amdgcn_sched_barrier(0); \
              wsfB = *(const PG8_LAS bf16x8*)(rw + 1024); PG8_GMMA(0, wsfA); PG8_GGELU(ai, kb, 1); __builtin_amdgcn_sched_barrier(0); \
              wsfA = *(const PG8_LAS bf16x8*)(rw + 2048); PG8_GMMA(1, wsfB); PG8_GGELU(ai, kb, 2); __builtin_amdgcn_sched_barrier(0); \
              wsfB = *(const PG8_LAS bf16x8*)(rw + 3072); PG8_GMMA(2, wsfA); PG8_GGELU(ai, kb, 3); __builtin_amdgcn_sched_barrier(0); \
              PG8_GMMA(3, wsfB); } \
            __builtin_amdgcn_sched_barrier(0); \
            if (kb == 3) {     \
                f32x4 gv[2][2]; \
                _Pragma("unroll") for (int bj = 0; bj < 2; ++bj) { gv[bj][0] = *(const PG8_LAS f32x4*)(lb + GTAB + (wc * 32 + 8 * fq + bj * HALF) * 4); gv[bj][1] = *(const PG8_LAS f32x4*)(lb + GTAB + (wc * 32 + 8 * fq + bj * HALF) * 4 + 16); } \
                _Pragma("unroll") for (int m = 0; m < 4; ++m) { const int p = wr * 64 + m * 16 + fr; const float bsv = *(const PG8_LAS float*)(lb + GTAB + 1024 + p * 4); \
                    bf16_t* rowp = Gt + (size_t)(u.pm * BM + ai * HALF + p) * ldc + u.pn * BM + wc * 32 + 8 * fq; \
                    _Pragma("unroll") for (int bj = 0; bj < 2; ++bj) { const f32x4 v0 = acc[ai][bj][m][0] * (mx[bj][m][0] * gv[bj][0] + bsv), v1 = acc[ai][bj][m][1] * (mx[bj][m][1] * gv[bj][1] + bsv); \
                        u32x4 w; w.x = cvt_pk_bf16(v0[0], v0[1]); w.y = cvt_pk_bf16(v0[2], v0[3]); w.z = cvt_pk_bf16(v1[0], v1[1]); w.w = cvt_pk_bf16(v1[2], v1[3]); \
                        *(u32x4*)(rowp + bj * HALF) = w; } } \
                __builtin_amdgcn_sched_barrier(0); } } while (0)
        PG8_GSTEP(0, 6); PG8_GSTEP(1, 3); PG8_GSTEP(2, 3); PG8_GSTEP(3, 3); PG8_GSTEP(4, 11); PG8_GSTEP(5, 11); PG8_GSTEP(6, 3); PG8_GSTEP(7, 0);
        asm volatile("s_waitcnt lgkmcnt(0)" ::: "memory"); __builtin_amdgcn_s_barrier(); asm volatile("" ::: "memory");
#undef PG8_GSTEP
#undef PG8_GMMA
#undef PG8_GGELU
#undef PG8_GISSUE
#undef PG8_GADDR
#undef PG8_GSB
    }
};

struct EpiResid {
    static constexpr bool PERM = true, PREF = false, RESTAGE = false;
    bf16_t* X; int ldc; const float* gate; int gstride; bf16_t* XS; const float* gsn; int gsstride; float* ssn; const float* xin0; const float* xin1;
    __device__ __forceinline__ void prefetch(const Unit&, int, int) const {}
    __device__ __forceinline__ void operator()(f32x4 (&acc)[2][2][4][2], const Unit& u, int wr, int wc, int fr, int fq, int) const {
        const int row0 = u.pm * BM + wr * 64 + fr, col0 = u.pn * BM + wc * 32 + 8 * fq;
        const int b = batch_of_tile(u.pm);
        const float* gp = gate + (size_t)b * gstride + col0;
        int ln = fq * 16 + fr; asm volatile("" : "+v"(ln));
        f32x4 gv[2][2], sv[2][2];
#pragma unroll
        for (int bj = 0; bj < 2; ++bj) { gv[bj][0] = *(const f32x4*)(gp + bj * HALF); gv[bj][1] = *(const f32x4*)(gp + bj * HALF + 4); }
        if (XS) { const float* sp_ = gsn + (size_t)b * gsstride + col0;
#pragma unroll
            for (int bj = 0; bj < 2; ++bj) { sv[bj][0] = *(const f32x4*)(sp_ + bj * HALF); sv[bj][1] = *(const f32x4*)(sp_ + bj * HALF + 4); } }
#pragma unroll
        for (int ai = 0; ai < 2; ++ai)
#pragma unroll
            for (int mp = 0; mp < 2; ++mp) {
                f32x4 xx[2][2][2];
#pragma unroll
                for (int mm = 0; mm < 2; ++mm) { const int rrow = row0 + ai * HALF + (2 * mp + mm) * 16;
                    if (xin0) { const float* rowp = (u.pm < 64 ? xin0 + (size_t)rrow * ldc : xin1 + (size_t)(rrow - 16384) * ldc) + col0;
#pragma unroll
                        for (int bj = 0; bj < 2; ++bj) { xx[mm][bj][0] = *(const f32x4*)(rowp + bj * HALF); xx[mm][bj][1] = *(const f32x4*)(rowp + bj * HALF + 4); } }
                    else { const bf16_t* rowp = X + (size_t)rrow * ldc + col0;
#pragma unroll
                        for (int bj = 0; bj < 2; ++bj) { const u32x4 w = *(const u32x4*)(rowp + bj * HALF);
                            xx[mm][bj][0] = (f32x4){__builtin_bit_cast(float, w.x << 16), __builtin_bit_cast(float, w.x & 0xffff0000u), __builtin_bit_cast(float, w.y << 16), __builtin_bit_cast(float, w.y & 0xffff0000u)};
                            xx[mm][bj][1] = (f32x4){__builtin_bit_cast(float, w.z << 16), __builtin_bit_cast(float, w.z & 0xffff0000u), __builtin_bit_cast(float, w.w << 16), __builtin_bit_cast(float, w.w & 0xffff0000u)}; } } }
#pragma unroll
                for (int mm = 0; mm < 2; ++mm) { const int m = 2 * mp + mm, row = row0 + ai * HALF + m * 16; float ssq = 0.f;
#pragma unroll
                    for (int bj = 0; bj < 2; ++bj) { const f32x4 x0 = xx[mm][bj][0] + gv[bj][0] * acc[ai][bj][m][0], x1 = xx[mm][bj][1] + gv[bj][1] * acc[ai][bj][m][1];
                        u32x4 xw; xw.x = cvt_pk_bf16(x0[0], x0[1]); xw.y = cvt_pk_bf16(x0[2], x0[3]); xw.z = cvt_pk_bf16(x1[0], x1[1]); xw.w = cvt_pk_bf16(x1[2], x1[3]);
                        *(u32x4*)(X + (size_t)row * ldc + col0 + bj * HALF) = xw;
                        if (XS) { ssq += ((x0[0] * x0[0] + x0[1] * x0[1]) + (x0[2] * x0[2] + x0[3] * x0[3])) + ((x1[0] * x1[0] + x1[1] * x1[1]) + (x1[2] * x1[2] + x1[3] * x1[3]));
                            const f32x4 y0 = x0 * sv[bj][0], y1 = x1 * sv[bj][1];
                            u32x4 w; w.x = cvt_pk_bf16(y0[0], y0[1]); w.y = cvt_pk_bf16(y0[2], y0[3]); w.z = cvt_pk_bf16(y1[0], y1[1]); w.w = cvt_pk_bf16(y1[2], y1[3]);
                            *(u32x4*)(XS + (size_t)row * ldc + col0 + bj * HALF) = w; } }
                    if (XS) { ssq += shfl_xor_l(ssq, 16, ln); ssq += shfl_xor_l(ssq, 32, ln); if (fq == 0) atomicAdd((unsigned*)ssn + row, (unsigned)(ssq * SSQ_SCALE + 0.5f)); } }
                asm volatile("" ::: "memory"); }
    }
};

template <class Epi, class Sched, bool ALIGN_EPI>
__device__ __forceinline__ void gemm_phase(PG8_LAS unsigned char* lds, const Gemm g, const Sched& S, const Epi& E, const int wave_s) {
    int wid_ = wave_s; asm volatile("" : "+s"(wid_));
    const int wid = wid_, wr = wid >> 2, wc = wid & 3;
    const int K = g.K, nt = K / BK;
    unsigned voffA[2], voffB[2]; int aoff, boff;
#define PG8_LANE_SETUP() do { const int lane_ = lane_asm(), tid_ = wid * 64 + lane_, fr_ = lane_ & 15, fq_ = lane_ >> 4; \
        _Pragma("unroll") for (int i = 0; i < 2; ++i) { int R, C; stage_rc(tid_ * 16 + i * 8192, R, C); const int Rb = Epi::PERM ? ((R & ~31) + perm32(R & 31)) : R; \
            voffA[i] = (unsigned)(R * g.lda + C) * 2u; voffB[i] = (unsigned)(Rb * g.ldb + C) * 2u; } \
        aoff = lds_byte(wr * 64 + fr_, fq_ * 8); boff = lds_byte(wc * 32 + fr_, fq_ * 8); } while (0)
    PG8_LANE_SETUP();
    const size_t kstep = (size_t)(BK * 2);
    const size_t hstepA = (size_t)HALF * g.lda * 2, hstepB = (size_t)HALF * g.ldb * 2;
    const size_t tstepA = 2 * hstepA, tstepB = 2 * hstepB;
    const unsigned ldsw = (unsigned)wid * 1024u;
#define PG8_ABASE(u) ((const char*)g.A + (size_t)(u).pm * tstepA + (size_t)(((u).pn >> g.a_kshift) * g.a_kcols) * 2)
#define PG8_BBASE(u) ((const char*)g.Bt + (size_t)(u).pn * tstepB)
#define PG8_SA(b, h) (((b) * 2 + (h)) * HTB)
#define PG8_SB(b, h) ((4 + (b) * 2 + (h)) * HTB)
#define PG8_STAGE(bufoff, gbase, voff) do { _Pragma("unroll") for (int _i = 0; _i < 2; ++_i) \
        __builtin_amdgcn_global_load_lds((const unsigned*)((const char*)(gbase) + (voff)[_i]), (PG8_LAS unsigned*)(lds + (bufoff) + ldsw + _i * 8192), 16, 0, 0); } while (0)
#define PG8_LDA(dst, b, h) do { _Pragma("unroll") for (int m = 0; m < 4; ++m) _Pragma("unroll") for (int k = 0; k < 2; ++k) dst[m][k] = *(const PG8_LAS bf16x8*)(lds + PG8_SA(b, h) + aoff + m * 2048 + k * 1024); } while (0)
#define PG8_LDB(dst, b, h) do { _Pragma("unroll") for (int n = 0; n < 2; ++n) _Pragma("unroll") for (int k = 0; k < 2; ++k) dst[n][k] = *(const PG8_LAS bf16x8*)(lds + PG8_SB(b, h) + boff + n * 2048 + k * 1024); } while (0)
#define PG8_MMA(ai, bj, At, Bt) do { __builtin_amdgcn_s_setprio(1); _Pragma("unroll") for (int m = 0; m < 4; ++m) _Pragma("unroll") for (int n = 0; n < 2; ++n) _Pragma("unroll") for (int k = 0; k < 2; ++k) \
        acc[ai][bj][m][n] = __builtin_amdgcn_mfma_f32_16x16x32_bf16(Bt[n][k], At[m][k], acc[ai][bj][m][n], 0, 0, 0); __builtin_amdgcn_s_setprio(0); } while (0)
#define PG8_MMA_HEAD(ai, At, B0_) do { __builtin_amdgcn_s_setprio(1); _Pragma("unroll") for (int k = 0; k < 2; ++k) \
        acc[ai][0][0][0] = __builtin_amdgcn_mfma_f32_16x16x32_bf16(B0_[0][k], At[0][k], acc[ai][0][0][0], 0, 0, 0); } while (0)
#define PG8_MMA_TAIL(ai, At, B0_, B1_) do { _Pragma("unroll") for (int k = 0; k < 2; ++k) acc[ai][0][0][1] = __builtin_amdgcn_mfma_f32_16x16x32_bf16(B0_[1][k], At[0][k], acc[ai][0][0][1], 0, 0, 0); \
        _Pragma("unroll") for (int m = 1; m < 4; ++m) _Pragma("unroll") for (int n = 0; n < 2; ++n) _Pragma("unroll") for (int k = 0; k < 2; ++k) \
        acc[ai][0][m][n] = __builtin_amdgcn_mfma_f32_16x16x32_bf16(B0_[n][k], At[m][k], acc[ai][0][m][n], 0, 0, 0); \
        _Pragma("unroll") for (int m = 0; m < 4; ++m) _Pragma("unroll") for (int n = 0; n < 2; ++n) _Pragma("unroll") for (int k = 0; k < 2; ++k) \
        acc[ai][1][m][n] = __builtin_amdgcn_mfma_f32_16x16x32_bf16(B1_[n][k], At[m][k], acc[ai][1][m][n], 0, 0, 0); __builtin_amdgcn_s_setprio(0); } while (0)
#define PG8_WAIT_V(n) asm volatile("s_waitcnt vmcnt(" #n ")" ::: "memory")
#define PG8_WAIT_L(n) asm volatile("s_waitcnt lgkmcnt(" #n ")" ::: "memory")
#define PG8_BAR __builtin_amdgcn_s_barrier()
#define PG8_SCHED __builtin_amdgcn_sched_barrier(0)
    Unit cur, nxt; int ui = 0;
    if (!S.next(0, cur)) return;
    f32x4 acc[2][2][4][2];
#pragma unroll
    for (int a = 0; a < 2; ++a)
#pragma unroll
        for (int b = 0; b < 2; ++b)
#pragma unroll
            for (int m = 0; m < 4; ++m)
#pragma unroll
                for (int n = 0; n < 2; ++n) acc[a][b][m][n] = (f32x4){0.f, 0.f, 0.f, 0.f};
    bf16x8 At[4][2], B0[2][2], B1[2][2];
    const char* cA = PG8_ABASE(cur); const char* cB = PG8_BBASE(cur);
    S.a_ready(cur);
    if constexpr (Epi::PREF) E.prefetch(cur, wid, 0);
    PG8_STAGE(PG8_SB(0, 0), cB, voffB); PG8_STAGE(PG8_SB(0, 1), cB + hstepB, voffB); PG8_STAGE(PG8_SA(0, 0), cA, voffA); PG8_STAGE(PG8_SA(0, 1), cA + hstepA, voffA);
    if (wr == 1) PG8_BAR;
    PG8_WAIT_V(2); PG8_BAR;
    PG8_STAGE(PG8_SB(1, 0), cB + kstep, voffB); PG8_STAGE(PG8_SA(1, 0), cA + kstep, voffA); PG8_STAGE(PG8_SB(1, 1), cB + hstepB + kstep, voffB);
    PG8_WAIT_V(6); PG8_BAR;
    for (;;) {
        const bool has_next = S.next(ui + 1, nxt);
        const char* nA = has_next ? PG8_ABASE(nxt) : cA; const char* nB = has_next ? PG8_BBASE(nxt) : cB;
        for (int t = 0; t < nt; t += 2) {
            const bool last = (t == nt - 2);
            const char* a1 = cA + (size_t)(t + 1) * kstep;
            const char* a2 = last ? nA : cA + (size_t)(t + 2) * kstep; const char* b2 = last ? nB : cB + (size_t)(t + 2) * kstep;
            const char* a3 = a2 + kstep; const char* b3 = b2 + kstep;
            if (last && has_next) S.a_ready(nxt);
            PG8_LDB(B0, 0, 0); PG8_LDB(B1, 0, 1); PG8_SCHED; PG8_LDA(At, 0, 0); PG8_STAGE(PG8_SA(1, 1), a1 + hstepA, voffA);
            PG8_WAIT_V(8); PG8_WAIT_L(0); PG8_MMA_HEAD(0, At, B0); PG8_SCHED; PG8_BAR; PG8_SCHED; PG8_MMA_TAIL(0, At, B0, B1); PG8_BAR; PG8_SCHED;
            PG8_LDA(At, 0, 1); PG8_STAGE(PG8_SB(0, 0), b2, voffB); PG8_STAGE(PG8_SB(0, 1), b2 + hstepB, voffB); PG8_STAGE(PG8_SA(0, 0), a2, voffA);
            PG8_WAIT_V(8); PG8_WAIT_L(0); PG8_MMA_HEAD(1, At, B0); PG8_SCHED; PG8_BAR; PG8_SCHED; PG8_MMA_TAIL(1, At, B0, B1); PG8_BAR; PG8_SCHED;
            PG8_LDB(B0, 1, 0); PG8_LDB(B1, 1, 1); PG8_SCHED; PG8_LDA(At, 1, 0); PG8_STAGE(PG8_SA(0, 1), a2 + hstepA, voffA);
            PG8_WAIT_V(8); PG8_WAIT_L(0); PG8_MMA_HEAD(0, At, B0); PG8_SCHED; PG8_BAR; PG8_SCHED; PG8_MMA_TAIL(0, At, B0, B1); PG8_BAR; PG8_SCHED;
            PG8_LDA(At, 1, 1); if (!(Epi::RESTAGE && last)) { PG8_STAGE(PG8_SB(1, 0), b3, voffB); PG8_STAGE(PG8_SB(1, 1), b3 + hstepB, voffB); PG8_STAGE(PG8_SA(1, 0), a3, voffA); }
            PG8_WAIT_V(8); PG8_WAIT_L(0); PG8_MMA_HEAD(1, At, B0); PG8_SCHED; PG8_BAR; PG8_SCHED; PG8_MMA_TAIL(1, At, B0, B1); PG8_BAR; PG8_SCHED;
        }
        if constexpr (ALIGN_EPI) { if (wr == 0) PG8_BAR; }
        if constexpr (Epi::PREF && Epi::RESTAGE) { if (has_next) E.prefetch(nxt, wid, (ui + 1) & 1); }
        if constexpr (Epi::RESTAGE) { if (ui == 0) E.late_wait(wid); }
        { const int lane_e = lane_asm(); E(acc, cur, wr, wc, lane_e & 15, lane_e >> 4, ui & 1); } S.done(cur);
        if constexpr (Epi::PREF && !Epi::RESTAGE) { if (has_next) E.prefetch(nxt, wid, (ui + 1) & 1); }
        if (!has_next) break;
#pragma unroll
        for (int a = 0; a < 2; ++a)
#pragma unroll
            for (int b = 0; b < 2; ++b)
#pragma unroll
                for (int m = 0; m < 4; ++m)
#pragma unroll
                    for (int n = 0; n < 2; ++n) acc[a][b][m][n] = (f32x4){0.f, 0.f, 0.f, 0.f};
        cur = nxt; cA = nA; cB = nB; ++ui;
        PG8_LANE_SETUP();
        if constexpr (Epi::RESTAGE) { PG8_STAGE(PG8_SB(1, 0), cB + kstep, voffB); PG8_STAGE(PG8_SB(1, 1), cB + hstepB + kstep, voffB); PG8_STAGE(PG8_SA(1, 0), cA + kstep, voffA); }
        if constexpr (ALIGN_EPI) { if (wr == 1) PG8_BAR; }
    }
    PG8_WAIT_V(0);
    if constexpr (!ALIGN_EPI) { if (wr == 0) PG8_BAR; }
    PG8_BAR;
#undef PG8_LANE_SETUP
#undef PG8_ABASE
#undef PG8_BBASE
#undef PG8_SA
#undef PG8_SB
#undef PG8_STAGE
#undef PG8_LDA
#undef PG8_LDB
#undef PG8_MMA
#undef PG8_MMA_HEAD
#undef PG8_MMA_TAIL
#undef PG8_WAIT_V
#undef PG8_WAIT_L
#undef PG8_BAR
#undef PG8_SCHED
}
}

constexpr int NWAVES = 8;
constexpr int D = 2048, T = 32768, DEPTH = 4, NBATCH = 3;
constexpr int FF = 8192, SFF = 12288, SHALF = 6144, NHEADS = 8, HDIM = 768, CHUNK = 128, NMOD = 6, PGRP = 512;
constexpr int VTLD = T + 64;
constexpr int NSSP = 48;
constexpr float EPS = 1e-6f;

constexpr size_t MiB = 1u << 20;
constexpr size_t WS_CTL = 0, CTL_ZERO_BYTES = 57344;
constexpr size_t WS_MODV = 1 * MiB;
constexpr size_t WS_SSP = 2 * MiB;
constexpr size_t WS_WPIN = 8 * MiB;
constexpr size_t WS_WPGRP = 24 * MiB;
constexpr size_t WS_WPOUT = 28 * MiB;
constexpr size_t WS_WSIN = 44 * MiB;
constexpr size_t WS_WSOUT = 140 * MiB;
constexpr size_t WS_W1 = 188 * MiB;
constexpr size_t WS_W2 = 316 * MiB;
constexpr size_t WS_H = 444 * MiB;
constexpr size_t WS_BIG = 572 * MiB;
constexpr size_t WS_WSS = 1341 * MiB;
constexpr size_t WS_SSX = 1405 * MiB;
constexpr size_t SSX_BYTES = (size_t)9 * 32768 * 4;
constexpr size_t WS_GS = 64 * 1024;
constexpr size_t WS_CVM = 1407 * MiB;
constexpr size_t WS_CV1 = 1 * MiB + 640 * 1024;
constexpr size_t WS_XB = 1408 * MiB;
constexpr size_t WS_END = 1536 * MiB;
constexpr int CW_BAR = 4096;

#define LAS __attribute__((address_space(3)))
typedef unsigned short bf16;
typedef unsigned v4u __attribute__((ext_vector_type(4)));
typedef unsigned v2u __attribute__((ext_vector_type(2)));
typedef float f32x4 __attribute__((ext_vector_type(4)));
typedef short bf16x8 __attribute__((ext_vector_type(8)));
#define LDS_WAIT() asm volatile("s_waitcnt lgkmcnt(0)" ::: "memory")
__device__ __forceinline__ unsigned f2bf(float f) { unsigned u = __builtin_bit_cast(unsigned, f); return (u + 0x7fffu + ((u >> 16) & 1u)) >> 16; }
__device__ __forceinline__ unsigned pk2(float lo, float hi) { return f2bf(lo) | (f2bf(hi) << 16); }
__device__ __forceinline__ float bflo(unsigned w) { return __builtin_bit_cast(float, w << 16); }
__device__ __forceinline__ float bfhi(unsigned w) { return __builtin_bit_cast(float, w & 0xffff0000u); }

#define XB_TMO      128
#define XB_XCNT(j)  (256  + 64 * (j))
#define XB_XSUB(j)  (1280 + 64 * (j))
#define XB_XGEN(j)  (2304 + 64 * (j))
#define XB_TOP      3328
#define XB_TOPGEN   3392
#define XCD_BAR_WORDS 3456
#define XB_XSUB2(j) (3456 + 64 * (j))
#define XB_TOP2     4480
#define XB_TOPGEN2  4544
#define XB_XGEN2(j) (4608 + 64 * (j))
#define XB_LSUB(j)  (7808 + 64 * (j))
#define XB_LGEN(j)  (8832 + 64 * (j))
#define XB_SET(s)   ((s) * 2176u)
#define XB_SPIN_CAP (1u << 18)

__device__ __forceinline__ unsigned xb_ld(unsigned* p)              { return __hip_atomic_load(p, __ATOMIC_RELAXED, __HIP_MEMORY_SCOPE_AGENT); }
__device__ __forceinline__ unsigned xb_add(unsigned* p, unsigned v) { return __hip_atomic_fetch_add(p, v, __ATOMIC_RELAXED, __HIP_MEMORY_SCOPE_AGENT); }
__device__ __forceinline__ unsigned xb_xcc_id() { return (unsigned)__builtin_amdgcn_s_getreg((3 << 11) | 20) & 0xFu; }
#define XB_SPIN(cond, bar) do { unsigned _sp = 0; while (cond) { __builtin_amdgcn_s_sleep(1); \
    if ((++_sp & 255u) == 0u) { if (xb_ld(&(bar)[XB_TMO])) break; if (_sp > XB_SPIN_CAP) { atomicAdd(&(bar)[XB_TMO], 1u); break; } } } } while (0)

struct XcdBarrier {
    unsigned* bar; unsigned x;
    volatile LAS unsigned* st;
};
__device__ __forceinline__ XcdBarrier xcd_barrier_post(unsigned* bar, volatile LAS unsigned* st) {
    XcdBarrier b; b.bar = bar; b.x = xb_xcc_id(); b.st = st;
    if (threadIdx.x == 0) { const unsigned rank = xb_add(&bar[XB_XCNT(b.x)], 1u); st[2] = rank; st[3] = b.x; }
    return b;
}
__device__ __forceinline__ void xcd_barrier_complete(unsigned* bar, unsigned x, unsigned& nloc, unsigned& nx) {
    const unsigned G = gridDim.x * gridDim.y * gridDim.z;
    unsigned sum, cnt, mine, sp = 0u;
    for (;;) {
        sum = 0u; cnt = 0u; mine = 0u;
#pragma unroll
        for (unsigned j = 0; j < 16; ++j) { const unsigned c = xb_ld(&bar[XB_XCNT(j)]); sum += c; cnt += (c > 0u) ? 1u : 0u; mine = (j == x) ? c : mine; }
        if (sum == G) break;
        __builtin_amdgcn_s_sleep(1);
        if ((++sp & 255u) == 0u) { if (xb_ld(&bar[XB_TMO])) break; if (sp > XB_SPIN_CAP) { atomicAdd(&bar[XB_TMO], 1u); break; } }
    }
    nloc = mine > 0u ? mine : 1u; nx = cnt > 0u ? cnt : 1u;
}
__device__ __forceinline__ void xcd_barrier(const XcdBarrier& b, const int wave_s) {
    asm volatile("s_waitcnt vmcnt(0)" ::: "memory");
    __syncthreads();
    if (wave_s == 0 && pg8::lane_asm() == 0) {
        unsigned* bar = b.bar; asm volatile("" : "+s"(bar));
        __builtin_amdgcn_s_waitcnt(0);
        const unsigned bx_ = xb_xcc_id();
        unsigned nloc = b.st[0], nx = b.st[1];
        if (nloc == 0u) { xcd_barrier_complete(bar, bx_, nloc, nx); b.st[0] = nloc; b.st[1] = nx; }
        const unsigned old = xb_add(&bar[XB_XSUB(bx_)], 1u);
        const unsigned gen = old / nloc;
        if (old + 1u == (gen + 1u) * nloc) {
            __builtin_amdgcn_fence(__ATOMIC_RELEASE, "agent");
            asm volatile("s_waitcnt vmcnt(0)" ::: "memory");
            const unsigned og = xb_add(&bar[XB_TOP], 1u);
            const unsigned tg = og / nx;
            if (og + 1u == (tg + 1u) * nx) xb_add(&bar[XB_TOPGEN], 1u);
            else XB_SPIN(xb_ld(&bar[XB_TOPGEN]) == tg, bar);
            __builtin_amdgcn_fence(__ATOMIC_ACQUIRE, "agent");
            xb_add(&bar[XB_XGEN(bx_)], 1u);
            asm volatile("s_waitcnt vmcnt(0)" ::: "memory");
        } else {
            XB_SPIN(xb_ld(&bar[XB_XGEN(bx_)]) == gen, bar);
            __builtin_amdgcn_fence(__ATOMIC_ACQUIRE, "agent");
            asm volatile("s_waitcnt vmcnt(0)" ::: "memory");
        }
    }
    __syncthreads();
}
__device__ __forceinline__ void xcd_local_barrier(const XcdBarrier& b, const int wave_s) {
    asm volatile("s_waitcnt vmcnt(0)" ::: "memory");
    __syncthreads();
    if (wave_s == 0 && pg8::lane_asm() == 0) {
        unsigned* bar = b.bar; asm volatile("" : "+s"(bar));
        __builtin_amdgcn_s_waitcnt(0);
        const unsigned bx_ = xb_xcc_id();
        const unsigned nloc = b.st[0];
        const unsigned old = xb_add(&bar[XB_LSUB(bx_)], 1u);
        const unsigned gen = old / nloc;
        if (old + 1u == (gen + 1u) * nloc) xb_add(&bar[XB_LGEN(bx_)], 1u);
        else XB_SPIN(xb_ld(&bar[XB_LGEN(bx_)]) == gen, bar);
        __builtin_amdgcn_fence(__ATOMIC_ACQUIRE, "agent");
        asm volatile("s_waitcnt vmcnt(0)" ::: "memory");
    }
    __syncthreads();
}
__device__ __forceinline__ void xcd_arrive2(const XcdBarrier& b, const int wave_s, const unsigned setoff = 0u) {
    asm volatile("s_waitcnt vmcnt(0)" ::: "memory");
    __syncthreads();
    if (wave_s == 0 && pg8::lane_asm() == 0) {
        unsigned* bar = b.bar; asm volatile("" : "+s"(bar));
        __builtin_amdgcn_s_waitcnt(0);
        const unsigned bx_ = xb_xcc_id();
        unsigned nloc = b.st[0], nx = b.st[1];
        if (nloc == 0u) { xcd_barrier_complete(bar, bx_, nloc, nx); b.st[0] = nloc; b.st[1] = nx; }
        const unsigned old = xb_add(&bar[setoff + XB_XSUB2(bx_)], 1u);
        const unsigned gen = old / nloc;
        if (old + 1u == (gen + 1u) * nloc) {
            __builtin_amdgcn_fence(__ATOMIC_RELEASE, "agent");
            asm volatile("s_waitcnt vmcnt(0)" ::: "memory");
            const unsigned og = xb_add(&bar[setoff + XB_TOP2], 1u);
            const unsigned tg = og / nx;
            if (og + 1u == (tg + 1u) * nx) {
                xb_add(&bar[setoff + XB_TOPGEN2], 1u);
#pragma unroll
                for (unsigned jx = 0; jx < 16; ++jx) xb_add(&bar[setoff + XB_XGEN2(jx)], 1u);
            }
            asm volatile("s_waitcnt vmcnt(0)" ::: "memory");
        }
    }
}
__device__ __forceinline__ void xcd_wait2(unsigned* bar_, unsigned target, int wid, unsigned setoff) {
    if (wid == 0 && pg8::lane_asm() == 0) {
        unsigned* bar = bar_; asm volatile("" : "+s"(bar));
        const unsigned bx_ = xb_xcc_id();
        XB_SPIN(xb_ld(&bar[setoff + XB_XGEN2(bx_)]) < target, bar);
        __builtin_amdgcn_fence(__ATOMIC_ACQUIRE, "agent");
        asm volatile("s_waitcnt vmcnt(0)" ::: "memory");
    }
    asm volatile("" ::: "memory"); __builtin_amdgcn_s_barrier(); asm volatile("" ::: "memory");
}

constexpr int RING_OFF = 0, RING_BYTES = 131072;
constexpr int SPARE_OFF = RING_BYTES, SPARE_BYTES = 24576;
constexpr int TAB_OFF = SPARE_OFF + SPARE_BYTES + 128;
constexpr int MISC_OFF = SPARE_OFF + SPARE_BYTES;
constexpr int LDS_BYTES = 163840;

__device__ __forceinline__ int opaque_s(int v) { asm volatile("" : "+s"(v)); return v; }
__device__ __forceinline__ int otid(int wave_s) { return wave_s * 64 + pg8::lane_asm(); }
__device__ __forceinline__ float wave_sum(float v, int lane) {
#pragma unroll
    for (int o = 1; o < 64; o <<= 1) v += pg8::shfl_xor_l(v, o, lane);
    return v;
}

__device__ __forceinline__ void p0_transpose_item(const float* W, int K, int N, bf16* WT, LAS float* scr, int item, int lane) {
    const int nblk = N / 32, kb = item / nblk, nb = item % nblk, k0 = 64 * kb, n0 = 32 * nb;
#pragma unroll 8
    for (int i = 0; i < 32; ++i) { const int kk = 2 * i + (lane >> 5); scr[kk * 33 + (lane & 31)] = __builtin_nontemporal_load(W + (size_t)(k0 + kk) * N + n0 + (lane & 31)); }
    LDS_WAIT(); asm volatile("" ::: "memory");
    const int c = lane & 7;
#pragma unroll
    for (int j = 0; j < 4; ++j) { const int n = (lane >> 3) + 8 * j; const LAS float* s = scr + (8 * c) * 33 + n;
        v4u o; o.x = pk2(s[0 * 33], s[1 * 33]); o.y = pk2(s[2 * 33], s[3 * 33]); o.z = pk2(s[4 * 33], s[5 * 33]); o.w = pk2(s[6 * 33], s[7 * 33]);
        *(v4u*)(WT + (size_t)(n0 + n) * K + k0 + 8 * c) = o; }
    LDS_WAIT(); asm volatile("" ::: "memory");
}
__device__ __forceinline__ void p0_scale_item(const float* Wg, const float* scale, bf16* WG, int item, int lane) {
    const int mat = item >> 7;
#pragma unroll
    for (int q = 0; q < 8; ++q) { const size_t idx = (size_t)item * 2048 + q * 256 + lane * 4; const int e = (int)(idx & 511);
        const f32x4 w = *(const f32x4*)(Wg + idx) * *(const f32x4*)(scale + mat * 512 + e);
        v2u o; o.x = pk2(w[0], w[1]); o.y = pk2(w[2], w[3]); *(v2u*)(WG + idx) = o; }
}
__device__ __forceinline__ bool p0_stack(int& it, const float* W, int L, int K, int N, bf16* WT, LAS float* scr, int lane) {
    const int per = (K / 64) * (N / 32), tot = L * per;
    if (it >= tot) { it -= tot; return false; }
    const int l = it / per, r = it % per;
    p0_transpose_item(W + (size_t)l * K * N, K, N, WT + (size_t)l * K * N, scr, r, lane);
    return true;
}

__device__ __forceinline__ void gemv3_item(const float* W, size_t ldw, int e0, const LAS float* vec, const float* bias, float* out, size_t ostride, LAS float* red, int tid, int lane, int wave) {
    const int r4 = lane >> 4, c4 = (lane & 15) * 4;
    const float* wp = W + (size_t)(wave * 256 + r4) * ldw + e0 + c4;
    f32x4 a0 = {0.f, 0.f, 0.f, 0.f}, a1 = a0, a2 = a0;
#pragma unroll 16
    for (int it = 0; it < 64; ++it) { const f32x4 w = __builtin_nontemporal_load((const f32x4*)(wp + (size_t)it * 4 * ldw)); const int d = wave * 256 + it * 4 + r4;
        a0 += w * vec[d]; a1 += w * vec[2048 + d]; a2 += w * vec[4096 + d]; }
#pragma unroll
    for (int j = 0; j < 4; ++j) { a0[j] += __shfl_xor(a0[j], 16); a0[j] += __shfl_xor(a0[j], 32); a1[j] += __shfl_xor(a1[j], 16); a1[j] += __shfl_xor(a1[j], 32); a2[j] += __shfl_xor(a2[j], 16); a2[j] += __shfl_xor(a2[j], 32); }
    if (lane < 16) { *(LAS f32x4*)(red + (wave * 3 + 0) * 64 + c4) = a0; *(LAS f32x4*)(red + (wave * 3 + 1) * 64 + c4) = a1; *(LAS f32x4*)(red + (wave * 3 + 2) * 64 + c4) = a2; }
    __syncthreads();
    if (tid < 192) { const int b = tid / 64, c = tid % 64; float sacc = bias ? bias[e0 + c] : 0.f;
#pragma unroll
        for (int w = 0; w < 8; ++w) sacc += red[(w * 3 + b) * 64 + c];
        out[(size_t)b * ostride + e0 + c] = sacc; }
    __syncthreads();
}

struct Args {
    const float* in[20]; float* out; unsigned char* ws; int ph_lo, ph_hi;
};

__global__ void __launch_bounds__(NWAVES * 64, 2) enc_fwd(Args args) {
    extern __shared__ __attribute__((aligned(16))) unsigned char lds_raw[];
    LAS unsigned char* lds = (LAS unsigned char*)lds_raw;
    volatile LAS unsigned* MISC = (volatile LAS unsigned*)(lds + MISC_OFF);
    const int tid = threadIdx.x, lane = tid & 63, wave = __builtin_amdgcn_readfirstlane(tid >> 6), wave_s = wave;
    const int G = gridDim.x, bx = blockIdx.x;
    unsigned char* ws = args.ws;
    unsigned* ctl = (unsigned*)(ws + WS_CTL);
    bf16* X = (bf16*)(ws + WS_XB);
    float* MODV = (float*)(ws + WS_MODV);
    float* SSP = (float*)(ws + WS_SSP);
    bf16* Hb = (bf16*)(ws + WS_H);
    bf16* BIG = (bf16*)(ws + WS_BIG);

    for (int u = tid; u < 32; u += NWAVES * 64) ((LAS unsigned*)(lds + MISC_OFF))[u] = 0u;
    __syncthreads();
#if MK_PER_PHASE_LAUNCH
#define GRID_BAR() do { } while (0)
#else
    XcdBarrier bar = xcd_barrier_post(ctl + CW_BAR, MISC + 8);
#define GRID_BAR() xcd_barrier(bar, wave_s)
#endif
#if MK_PER_PHASE_LAUNCH
    const int lo = args.ph_lo;
#define IN(k) (lo == (k))
#else
#define IN(k) true
#endif
    unsigned long long echo_last = ECHO_MASK ? __builtin_amdgcn_s_memrealtime() : 0ull, echo_acc = 0ull;
#define ECHO_TICK(k) do { if (ECHO_MASK) { const unsigned long long now_ = __builtin_amdgcn_s_memrealtime(); if ((ECHO_MASK >> (k)) & 1ull) echo_acc += now_ - echo_last; echo_last = now_; } } while (0)
#define SEAM(k) do { if (IN(k) && IN((k) + 1)) GRID_BAR(); ECHO_TICK(k); } while (0)

    float* SSX = (float*)(ws + WS_SSX); float* GS = (float*)(ws + WS_GS); float* CVM = (float*)(ws + WS_CVM); float* CV1 = (float*)(ws + WS_CV1);
    if (IN(0) && !SKIP_P0) {
        { const f32x4 z4 = {0.f, 0.f, 0.f, 0.f}; for (int u = bx * (NWAVES * 64) + tid; u < 8 * T / 4; u += G * (NWAVES * 64)) *(f32x4*)(SSX + T + (size_t)u * 4) = z4; }
        LAS float* cact = (LAS float*)(lds + RING_OFF);
        LAS float* red = (LAS float*)(lds + RING_OFF + 32768);
        for (int u = tid; u < NBATCH * D; u += NWAVES * 64) { const int b = u / D, d = u % D; const float c = (b < 2) ? args.in[2][b * D + d] : args.in[3][d]; cact[u] = c / (1.0f + __expf(-c)); }
        __syncthreads();
        for (int item = bx; item < DEPTH * (NMOD * D / 64); item += G) {
            const int i = item / (NMOD * D / 64), e0 = (item % (NMOD * D / 64)) * 64;
            gemv3_item(args.in[6] + (size_t)i * D * (NMOD * D), NMOD * D, e0, cact, args.in[7] + (size_t)i * (NMOD * D), MODV + (size_t)i * NBATCH * (NMOD * D), NMOD * D, red, tid, lane, wave);
        }
#if !MK_PER_PHASE_LAUNCH
        xcd_arrive2(bar, wave_s, XB_SET(1));
#endif
        LAS float* scr = (LAS float*)(lds + RING_OFF + wave * 16384);
        const int gw = bx * NWAVES + wave, NGW = G * NWAVES;
        constexpr int NITEMS = 2 * (D / 64) * (D / 32) * 2 + 8 * (PGRP / 64) * (PGRP / 32) + 2 * (D / 64) * (SFF / 32) + 2 * (SHALF / 64) * (D / 32) + 4 * (D / 64) * (FF / 32) + 4 * (FF / 64) * (D / 32);
        for (int it0 = gw; it0 < NITEMS; it0 += NGW) {
            int it = it0;
            if (p0_stack(it, args.in[8], 2, D, D, (bf16*)(ws + WS_WPIN), scr, lane)) continue;
            if (it < 8 * (PGRP / 64) * (PGRP / 32)) { p0_scale_item(args.in[9], args.in[10], (bf16*)(ws + WS_WPGRP), it, lane); continue; }
            it -= 8 * (PGRP / 64) * (PGRP / 32);
            if (p0_stack(it, args.in[11], 2, D, D, (bf16*)(ws + WS_WPOUT), scr, lane)) continue;
            if (p0_stack(it, args.in[17], 4, D, FF, (bf16*)(ws + WS_W1), scr, lane)) continue;
            if (p0_stack(it, args.in[18], 4, FF, D, (bf16*)(ws + WS_W2), scr, lane)) continue;
            if (p0_stack(it, args.in[12], 2, D, SFF, (bf16*)(ws + WS_WSIN), scr, lane)) continue;
            p0_stack(it, args.in[16], 2, SHALF, D, (bf16*)(ws + WS_WSOUT), scr, lane);
        }
        __syncthreads();
    }
#if MK_PER_PHASE_LAUNCH
    SEAM(0);
#else
    xcd_arrive2(bar, wave_s, 0u); __syncthreads(); ECHO_TICK(0);
#endif
    int vcu = bx, xl = 0;
#if !MK_PER_PHASE_LAUNCH
    {   bool ok = (G % 8) == 0; unsigned* bw = ctl + CW_BAR;
#pragma unroll
        for (int jx = 0; jx < 16; ++jx) { const unsigned cjx = xb_ld(&bw[XB_XCNT(jx)]); ok = ok && (cjx == (jx < 8 ? (unsigned)(G / 8) : 0u)); }
        const unsigned rk = MISC[10], xc = MISC[11];
        if (ok && xc < 8u && rk < (unsigned)(G / 8)) { vcu = (int)(rk * 8u + xc); xl = 1; }
        vcu = __builtin_amdgcn_readfirstlane(vcu); xl = __builtin_amdgcn_readfirstlane(xl);
    }
#endif
    if (IN(1) && !SKIP_P0) {
#if !MK_PER_PHASE_LAUNCH
        xcd_wait2(ctl + CW_BAR, 1u, wave_s, XB_SET(1));
#endif
        {
            const int gt = bx * (NWAVES * 64) + tid;
            if (gt < 8 * NBATCH * D) { const int r = gt / (NBATCH * D), b = (gt / D) % NBATCH, c = gt % D, li = r >> 1, sub = r & 1;
                GS[gt] = args.in[sub ? 5 : 4][(size_t)li * D + c] * (1.0f + MODV[((size_t)li * NBATCH + b) * (NMOD * D) + (sub ? 4 : 1) * D + c]); }
        }
        {
            LAS float* gs = (LAS float*)(lds + RING_OFF);
            for (int rb = bx; rb < T / 128; rb += G) {
                const int r0 = rb * 128, b = r0 < 8192 ? 0 : (r0 < 16384 ? 1 : 2);
                { const int c = tid * 4; const f32x4 gq = *(const f32x4*)(args.in[4] + c), sc = *(const f32x4*)(MODV + (size_t)b * (NMOD * D) + D + c); *(LAS f32x4*)(gs + c) = gq * (sc + 1.0f); }
                __syncthreads();
                for (int rr = 0; rr < 16; rr += 2) { const int row = r0 + wave * 16 + rr;
                    const float* src = row < 16384 ? args.in[0] + (size_t)row * D : args.in[1] + (size_t)(row - 16384) * D;
                    f32x4 v[2][8];
#pragma unroll
                    for (int h = 0; h < 2; ++h)
#pragma unroll
                        for (int q = 0; q < 4; ++q) { v[h][2 * q] = *(const f32x4*)(src + (size_t)h * D + q * 512 + lane * 8); v[h][2 * q + 1] = *(const f32x4*)(src + (size_t)h * D + q * 512 + lane * 8 + 4); }
#pragma unroll
                    for (int h = 0; h < 2; ++h) { float ss = 0.f;
#pragma unroll
                        for (int q = 0; q < 4; ++q) { const f32x4 x0 = v[h][2 * q], x1 = v[h][2 * q + 1];
                            ss += ((x0[0] * x0[0] + x0[1] * x0[1]) + (x0[2] * x0[2] + x0[3] * x0[3])) + ((x1[0] * x1[0] + x1[1] * x1[1]) + (x1[2] * x1[2] + x1[3] * x1[3]));
                            const f32x4 o0 = x0 * *(const LAS f32x4*)(gs + q * 512 + lane * 8), o1 = x1 * *(const LAS f32x4*)(gs + q * 512 + lane * 8 + 4);
                            v4u w; w.x = pk2(o0[0], o0[1]); w.y = pk2(o0[2], o0[3]); w.z = pk2(o1[0], o1[1]); w.w = pk2(o1[2], o1[3]); *(v4u*)(Hb + (size_t)(row + h) * D + q * 512 + lane * 8) = w; }
                        ss = wave_sum(ss, lane); if (lane == 0) ((unsigned*)SSX)[row + h] = (unsigned)(ss * pg8::SSQ_SCALE + 0.5f); } }
                __syncthreads(); }
        }
#if !MK_PER_PHASE_LAUNCH
        xcd_wait2(ctl + CW_BAR, 1u, wave_s, 0u);
#endif
        {
            LAS float* vec = (LAS float*)(lds + RING_OFF);
            const int gw = bx * NWAVES + wave, NGW = G * NWAVES;
            for (int hf = 0; hf < 2; ++hf) {
                __syncthreads();
                for (int u = tid; u < 4 * NBATCH * (D / 4); u += NWAVES * 64) { const int sx = u / (NBATCH * (D / 4)), r = u % (NBATCH * (D / 4)), b = r / (D / 4), d4 = r % (D / 4), id = hf * 4 + sx, li = id >> 1, which = id & 1;
                    *(LAS f32x4*)(vec + (size_t)u * 4) = *(const f32x4*)(MODV + ((size_t)li * NBATCH + b) * (NMOD * D) + (which ? 3 : 0) * D + d4 * 4); }
                __syncthreads();
                for (int sx = 0; sx < 4; ++sx) { const int id = hf * 4 + sx, li = id >> 1, which = id & 1;
                    const LAS float* vs = vec + sx * (NBATCH * D);
                    const int N = which ? FF : ((li & 1) ? SFF : D);
                    const bf16* Wt = which ? (const bf16*)(ws + WS_W1) + (size_t)li * FF * D : ((li & 1) ? (const bf16*)(ws + WS_WSIN) + (size_t)(li >> 1) * SFF * D : (const bf16*)(ws + WS_WPIN) + (size_t)(li >> 1) * D * D);
                    float* out = which ? CV1 + (size_t)li * NBATCH * FF : CVM + (size_t)li * NBATCH * SFF; const size_t ostride = which ? FF : SFF;
                    for (int n = gw; n < N; n += 2 * NGW) {
                        const int n2 = n + NGW; const bool two = n2 < N; const int n2c = two ? n2 : n;
                        v4u wA[4], wB[4];
#pragma unroll
                        for (int q = 0; q < 4; ++q) wA[q] = *(const v4u*)(Wt + (size_t)n * D + q * 512 + lane * 8);
#pragma unroll
                        for (int q = 0; q < 4; ++q) wB[q] = *(const v4u*)(Wt + (size_t)n2c * D + q * 512 + lane * 8);
                        float a0 = 0.f, a1 = 0.f, a2 = 0.f, b0 = 0.f, b1 = 0.f, b2 = 0.f;
#pragma unroll
                        for (int q = 0; q < 4; ++q) { const LAS float* vp = vs + q * 512 + lane * 8;
                            const float wf[8] = {bflo(wA[q].x), bfhi(wA[q].x), bflo(wA[q].y), bfhi(wA[q].y), bflo(wA[q].z), bfhi(wA[q].z), bflo(wA[q].w), bfhi(wA[q].w)};
                            const float wg[8] = {bflo(wB[q].x), bfhi(wB[q].x), bflo(wB[q].y), bfhi(wB[q].y), bflo(wB[q].z), bfhi(wB[q].z), bflo(wB[q].w), bfhi(wB[q].w)};
#pragma unroll
                            for (int e = 0; e < 8; ++e) { const float v0 = vp[e], v1 = vp[D + e], v2 = vp[2 * D + e]; a0 += wf[e] * v0; a1 += wf[e] * v1; a2 += wf[e] * v2; b0 += wg[e] * v0; b1 += wg[e] * v1; b2 += wg[e] * v2; } }
                        a0 = wave_sum(a0, lane); a1 = wave_sum(a1, lane); a2 = wave_sum(a2, lane); b0 = wave_sum(b0, lane); b1 = wave_sum(b1, lane); b2 = wave_sum(b2, lane);
                        if (lane == 0) { out[n] = a0; out[ostride + n] = a1; out[2 * ostride + n] = a2; if (two) { out[n2] = b0; out[ostride + n2] = b1; out[2 * ostride + n2] = b2; } }
                    }
                }
            }
            __syncthreads();
        }
        __syncthreads();
    }
    SEAM(1);

    for (int i = 0; i < DEPTH; ++i) {
        const int j = i >> 1, pb = 2 + i * 6;
        const float* modl = MODV + (size_t)i * NBATCH * (NMOD * D);
        const float* ss1 = SSX + (size_t)(2 * i) * T; float* ss2 = SSX + (size_t)(2 * i + 1) * T; float* ss3 = SSX + (size_t)(2 * i + 2) * T;
        const float* cvm = CVM + (size_t)i * NBATCH * SFF; const float* cv1 = CV1 + (size_t)i * NBATCH * FF;
        if ((i & 1) == 0) {
            bf16* Z = BIG + (size_t)640 * MiB / 2; bf16* ZD = BIG + (size_t)512 * MiB / 2; bf16* WO2 = (bf16*)(ws + WS_WSS);
            if (IN(pb + 0)) {
                pg8::Gemm g{Hb, (const bf16*)(ws + WS_WPIN) + (size_t)j * D * D, D, D, T, D, D, 0, 0}; pg8::StaticOrder S; S.init(T, D, G, opaque_s(vcu));
                pg8::EpiBf16<0, true> E{Z, D, nullptr, ss1, cvm, SFF, lds + TAB_OFF};
                pg8::gemm_phase<pg8::EpiBf16<0, true>, pg8::StaticOrder, true>(lds + RING_OFF, g, S, E, wave_s);
            }
#if MK_PER_PHASE_LAUNCH
            SEAM(pb + 0);
#else
            xcd_arrive2(bar, wave_s);
#endif
            if (IN(pb + 1) && !SKIP_POOL) {
                {
                    pg8::Gemm g{(const bf16*)(ws + WS_WPOUT) + (size_t)j * D * D, (const bf16*)(ws + WS_WPGRP) + (size_t)j * D * PGRP, D, PGRP, D, D, PGRP, 1, PGRP}; pg8::StaticOrder S; S.init(D, D, G, opaque_s(vcu));
                    pg8::EpiBf16<0, false> E{WO2, D, nullptr, nullptr, nullptr, 0, lds + TAB_OFF};
                    pg8::gemm_phase<pg8::EpiBf16<0, false>, pg8::StaticOrder, true>(lds + RING_OFF, g, S, E, wave_s);
                }
#if !MK_PER_PHASE_LAUNCH
                xcd_wait2(ctl + CW_BAR, (unsigned)(i + 2), wave_s); ECHO_TICK(pb + 0);
#endif
                const int tid = otid(wave_s);
                int bxo = bx; asm volatile("" : "+s"(bxo));
                for (int seg = bxo; seg < T / 128; seg += G) {
                    const int half = tid >> 8, chunk = tid & 255, gsel = chunk >> 6, hw = 1 << gsel;
                    const int r0 = seg * 128 + half * 64;
                    const int s0 = r0 < 8192 ? 0 : (r0 < 16384 ? 8192 : 16384), s1 = r0 < 8192 ? 8192 : (r0 < 16384 ? 16384 : 32768);
                    const bf16* zc = Z + chunk * 8; bf16* oc = ZD + chunk * 8;
                    float sum[8];
#pragma unroll
                    for (int q = 0; q < 8; ++q) sum[q] = 0.f;
                    for (int t = r0 - hw; t <= r0 + hw - 1; ++t) if (t >= s0 && t < s1) { const v4u w = *(const v4u*)(zc + (size_t)t * D);
                        sum[0] += bflo(w.x); sum[1] += bfhi(w.x); sum[2] += bflo(w.y); sum[3] += bfhi(w.y); sum[4] += bflo(w.z); sum[5] += bfhi(w.z); sum[6] += bflo(w.w); sum[7] += bfhi(w.w); }
#pragma unroll 8
                    for (int t = r0; t < r0 + 64; ++t) {
                        const int lo_t = (t - hw > s0) ? t - hw : s0, hi_t = (t + hw - 1 < s1 - 1) ? t + hw - 1 : s1 - 1;
                        const float inv = 1.0f / (float)(hi_t - lo_t + 1);
                        const v4u zc4 = *(const v4u*)(zc + (size_t)t * D);
                        v4u add = {0u, 0u, 0u, 0u}, sub = {0u, 0u, 0u, 0u};
                        if (t + hw < s1) add = *(const v4u*)(zc + (size_t)(t + hw) * D);
                        if (t - hw >= s0) sub = *(const v4u*)(zc + (size_t)(t - hw) * D);
                        v4u o;
                        o.x = pk2(sum[0] * inv - bflo(zc4.x), sum[1] * inv - bfhi(zc4.x)); o.y = pk2(sum[2] * inv - bflo(zc4.y), sum[3] * inv - bfhi(zc4.y));
                        o.z = pk2(sum[4] * inv - bflo(zc4.z), sum[5] * inv - bfhi(zc4.z)); o.w = pk2(sum[6] * inv - bflo(zc4.w), sum[7] * inv - bfhi(zc4.w));
                        *(v4u*)(oc + (size_t)t * D) = o;
                        sum[0] += bflo(add.x) - bflo(sub.x); sum[1] += bfhi(add.x) - bfhi(sub.x); sum[2] += bflo(add.y) - bflo(sub.y); sum[3] += bfhi(add.y) - bfhi(sub.y);
                        sum[4] += bflo(add.z) - bflo(sub.z); sum[5] += bfhi(add.z) - bfhi(sub.z); sum[6] += bflo(add.w) - bflo(sub.w); sum[7] += bfhi(add.w) - bfhi(sub.w);
                    }
                }
            }
            SEAM(pb + 1);
            if (IN(pb + 3)) {
                pg8::Gemm g{ZD, WO2, D, D, T, D, D, 0, 0}; pg8::StaticOrder S; S.init(T, D, G, opaque_s(vcu));
                pg8::EpiResid E{X, D, modl + 2 * D, NMOD * D, Hb, GS + (size_t)(2 * i + 1) * NBATCH * D, D, ss2, i == 0 ? args.in[0] : (const float*)nullptr, args.in[1]};
                pg8::gemm_phase<pg8::EpiResid, pg8::StaticOrder, true>(lds + RING_OFF, g, S, E, wave_s);
            }
#if MK_PER_PHASE_LAUNCH
            SEAM(pb + 3);
#else
            if (xl) xcd_local_barrier(bar, wave_s); else GRID_BAR(); ECHO_TICK(pb + 3);
#endif
        } else {
            bf16* Gt = BIG; bf16* VT = BIG + (size_t)T * SHALF; bf16* WsS = (bf16*)(ws + WS_WSS);
            const bf16* wsin = (const bf16*)(ws + WS_WSIN) + (size_t)j * SFF * D;
            if (IN(pb + 0)) {
                pg8::Gemm g{wsin + (size_t)SHALF * D, Hb, D, D, SHALF, T, D, 0, 0}; pg8::StaticOrder S; S.init(SHALF, T, G, opaque_s(vcu), 4);
                pg8::EpiVT E{VT, VTLD, SSP, T, ss1, cvm + SHALF, SFF, lds + TAB_OFF};
                pg8::gemm_phase<pg8::EpiVT, pg8::StaticOrder, true>(lds + RING_OFF, g, S, E, wave_s);
            }
            SEAM(pb + 0);
            if (IN(pb + 1) && !SKIP_GATE) {
                LAS float* rinv = (LAS float*)(lds + RING_OFF);
                const float* w_s = args.in[14] + (size_t)j * NHEADS * CHUNK * CHUNK;
                const int tid = otid(wave_s);
                int bxo = bx; asm volatile("" : "+s"(bxo));
                for (int n = bxo; n < T / CHUNK; n += G) {
                    if (tid < CHUNK) { float sacc = 0.f;
#pragma unroll
                        for (int k = 0; k < NSSP; ++k) sacc += SSP[(size_t)k * T + n * CHUNK + tid];
                        rinv[tid] = 1.0f / sqrtf(sacc * (1.0f / SHALF) + EPS); }
                    __syncthreads();
#pragma unroll 8
                    for (int it = 0; it < 32; ++it) { const int h = it >> 2, unit = (it & 3) * 512 + tid, p = unit >> 4, q8 = unit & 15;
                        const float* wp = w_s + (size_t)h * CHUNK * CHUNK + p * CHUNK + q8 * 8;
                        const f32x4 w0 = *(const f32x4*)wp * *(const LAS f32x4*)(rinv + q8 * 8), w1 = *(const f32x4*)(wp + 4) * *(const LAS f32x4*)(rinv + q8 * 8 + 4);
                        v4u o; o.x = pk2(w0[0], w0[1]); o.y = pk2(w0[2], w0[3]); o.z = pk2(w1[0], w1[1]); o.w = pk2(w1[2], w1[3]);
                        *(v4u*)(WsS + ((((size_t)(n * 8 + h) * 8 + (p >> 4)) * 4 + (q8 >> 2)) * 64 + (q8 & 3) * 16 + (p & 15)) * 8) = o; }
                    __syncthreads();
                }
            }
#if MK_PER_PHASE_LAUNCH
            SEAM(pb + 1);
#else
            xcd_arrive2(bar, wave_s); ECHO_TICK(pb + 1);
#endif
            if (IN(pb + 2)) {
                pg8::Gemm g{Hb, wsin, D, D, T, SHALF, D, 0, 0}; pg8::StaticOrder S; S.init(T, SHALF, G, opaque_s(vcu));
                pg8::EpiGate E{Gt, SHALF, VT, VTLD, WsS, args.in[13] + (size_t)j * SHALF, args.in[15] + (size_t)j * NHEADS * CHUNK, lds, ss1, cvm, SFF, lds + TAB_OFF, MK_PER_PHASE_LAUNCH ? (unsigned*)nullptr : ctl + CW_BAR, (unsigned)(i + 2)};
                pg8::gemm_phase<pg8::EpiGate, pg8::StaticOrder, true>(lds + RING_OFF, g, S, E, wave_s);
            }
#if MK_PER_PHASE_LAUNCH
            SEAM(pb + 2);
#else
            if (xl) xcd_local_barrier(bar, wave_s); else GRID_BAR(); ECHO_TICK(pb + 2);
#endif
            if (IN(pb + 3)) {
                pg8::Gemm g{Gt, (const bf16*)(ws + WS_WSOUT) + (size_t)j * D * SHALF, SHALF, SHALF, T, D, SHALF, 0, 0}; pg8::StaticOrder S; S.init(T, D, G, opaque_s(vcu), 4, 1);
                pg8::EpiResid E{X, D, modl + 2 * D, NMOD * D, Hb, GS + (size_t)(2 * i + 1) * NBATCH * D, D, ss2, nullptr, nullptr};
                pg8::gemm_phase<pg8::EpiResid, pg8::StaticOrder, true>(lds + RING_OFF, g, S, E, wave_s);
            }
            SEAM(pb + 3);
        }

        bf16* A2 = BIG;
        if (IN(pb + 4)) {
            pg8::Gemm g{Hb, (const bf16*)(ws + WS_W1) + (size_t)i * FF * D, D, D, T, FF, D, 0, 0}; pg8::StaticOrder S; S.init(T, FF, G, opaque_s(vcu));
            pg8::EpiBf16<2, true> E{A2, FF, nullptr, ss2, cv1, FF, lds + TAB_OFF};
            pg8::gemm_phase<pg8::EpiBf16<2, true>, pg8::StaticOrder, true>(lds + RING_OFF, g, S, E, wave_s);
        }
#if MK_PER_PHASE_LAUNCH
        SEAM(pb + 4);
#else
        if (xl) xcd_local_barrier(bar, wave_s); else GRID_BAR(); ECHO_TICK(pb + 4);
#endif
        if (IN(pb + 5)) {
            pg8::Gemm g{A2, (const bf16*)(ws + WS_W2) + (size_t)i * D * FF, FF, FF, T, D, FF, 0, 0}; pg8::StaticOrder S; S.init(T, D, G, opaque_s(vcu), 4, 1);
            pg8::EpiResid E{X, D, modl + 5 * D, NMOD * D, (i + 1 < DEPTH) ? Hb : (bf16*)nullptr, GS + (size_t)(2 * i + 2 < 8 ? 2 * i + 2 : 0) * NBATCH * D, D, ss3, nullptr, nullptr};
            pg8::gemm_phase<pg8::EpiResid, pg8::StaticOrder, true>(lds + RING_OFF, g, S, E, wave_s);
        }
#if MK_PER_PHASE_LAUNCH
        SEAM(pb + 5);
#else
        if (xl && (i == 1 || i == DEPTH - 1)) xcd_local_barrier(bar, wave_s); else GRID_BAR(); ECHO_TICK(pb + 5);
#endif
    }

    if (IN(2 + DEPTH * 6)) {
        const float* fg = args.in[19];
        const int tid = otid(wave_s), lane = tid & 63, wave = __builtin_amdgcn_readfirstlane(tid >> 6);
        const int xq = vcu & 7, rq = vcu >> 3;
        const int rs = xl ? xq * (T / 8) + rq * NWAVES + wave : bx * NWAVES + wave, rstride = xl ? (G / 8) * NWAVES : G * NWAVES, rend = xl ? (xq + 1) * (T / 8) : T;
        for (int row = rs; row < rend; row += 2 * rstride) {
            const bool two = row + rstride < rend; const int row2 = two ? row + rstride : row;
            v4u w[4], w2[4];
#pragma unroll
            for (int q = 0; q < 4; ++q) w[q] = *(const v4u*)(X + (size_t)row * D + q * 512 + lane * 8);
#pragma unroll
            for (int q = 0; q < 4; ++q) w2[q] = *(const v4u*)(X + (size_t)row2 * D + q * 512 + lane * 8);
#pragma unroll
            for (int h = 0; h < 2; ++h) { if (h == 1 && !two) continue; float* orow = args.out + (size_t)(h ? row2 : row) * D; float ss = 0.f;
                f32x4 v[8];
#pragma unroll
                for (int q = 0; q < 4; ++q) { const v4u ww = h ? w2[q] : w[q]; v[2 * q] = (f32x4){bflo(ww.x), bfhi(ww.x), bflo(ww.y), bfhi(ww.y)}; v[2 * q + 1] = (f32x4){bflo(ww.z), bfhi(ww.z), bflo(ww.w), bfhi(ww.w)}; }
#pragma unroll
                for (int q = 0; q < 8; ++q) ss += (v[q][0] * v[q][0] + v[q][1] * v[q][1]) + (v[q][2] * v[q][2] + v[q][3] * v[q][3]);
                const float rinv = 1.0f / sqrtf(wave_sum(ss, lane) * (1.0f / D) + EPS);
#pragma unroll
                for (int q = 0; q < 8; ++q) { const int c = (q >> 1) * 512 + lane * 8 + (q & 1) * 4; const f32x4 g4 = *(const f32x4*)(fg + c); *(f32x4*)(orow + c) = v[q] * rinv * g4; } }
        }
    }
    if (ECHO_MASK) { ECHO_TICK(2 + DEPTH * 6);
        if (bx == 0 && otid(wave_s) < 64) { const unsigned long long t_end = __builtin_amdgcn_s_memrealtime() + (unsigned long long)ECHO_MUL * echo_acc; while (__builtin_amdgcn_s_memrealtime() < t_end) __builtin_amdgcn_s_sleep(8); } }
#undef IN
#undef SEAM
}

extern "C" void kernel_launch(void* const* d_in, const int* in_sizes, int n_in, void* d_out, int out_size, void* d_ws, size_t ws_size, hipStream_t stream) {
    static int grid = 0;
    if (grid == 0) {
        if (n_in != 20 || out_size != T * D || ws_size < WS_END) { fprintf(stderr, "kernel_launch: built for 20 inputs, out of %d floats, >= %zu bytes of workspace; got n_in %d, out %d, ws %zu; nothing launched\n", T * D, (size_t)WS_END, n_in, out_size, ws_size); grid = -1; return; }
        int dev = 0, cus = 0, per_cu = 0;
        if (hipGetDevice(&dev) != hipSuccess || hipDeviceGetAttribute(&cus, hipDeviceAttributeMultiprocessorCount, dev) != hipSuccess) { fprintf(stderr, "kernel_launch: hipGetDevice / hipDeviceGetAttribute failed\n"); grid = -1; return; }
        if (hipFuncSetAttribute((const void*)enc_fwd, hipFuncAttributeMaxDynamicSharedMemorySize, LDS_BYTES) != hipSuccess) { fprintf(stderr, "kernel_launch: hipFuncSetAttribute failed\n"); grid = -1; return; }
        if (hipOccupancyMaxActiveBlocksPerMultiprocessor(&per_cu, (const void*)enc_fwd, NWAVES * 64, LDS_BYTES) != hipSuccess || per_cu < 1) { fprintf(stderr, "kernel_launch: occupancy query reports %d workgroups per CU\n", per_cu); }
        (void)hipGetLastError();
        grid = cus;
    }
    if (grid < 0) return;
    if (hipMemsetAsync((char*)d_ws + WS_CTL, 0, CTL_ZERO_BYTES, stream) != hipSuccess) { fprintf(stderr, "kernel_launch: hipMemsetAsync failed\n"); return; }
    Args a{};
    for (int i = 0; i < 20; ++i) a.in[i] = (const float*)d_in[i];
    a.out = (float*)d_out; a.ws = (unsigned char*)d_ws;
    constexpr int NPH = 3 + DEPTH * 6;
#if MK_PER_PHASE_LAUNCH
    for (int p = 0; p < NPH; ++p) { a.ph_lo = p; a.ph_hi = p + 1; hipLaunchKernelGGL(enc_fwd, dim3(grid), dim3(NWAVES * 64), LDS_BYTES, stream, a); }
#else
    a.ph_lo = 0; a.ph_hi = NPH;
    hipLaunchKernelGGL(enc_fwd, dim3(grid), dim3(NWAVES * 64), LDS_BYTES, stream, a);
#endif
    const hipError_t le = hipPeekAtLastError();
    if (le != hipSuccess) fprintf(stderr, "kernel_launch: launch failed: %s\n", hipGetErrorName(le));
}
```
